# Optimizing an MI355X kernel written in HIP

```python
import jax, jax.numpy as jnp
from jax import lax
import numpy as np

D_MODEL = 1024
BATCH = 4
SEQ = 8192
DEPTH = 2

N_MIXERS = 2
N_META = 16
EXPAND = 2
E_POOL = EXPAND * D_MODEL
POOL_WINDOWS = (2, 4, 8, 16)
N_POOL_GROUPS = len(POOL_WINDOWS)
POOL_GROUP_DIM = E_POOL // N_POOL_GROUPS
E_HGRN = EXPAND * D_MODEL
HGRN_HEAD_DIM = 128
N_HGRN_HEADS = E_HGRN // HGRN_HEAD_DIM
CHUNK = 64
PAD_FRONT = (-N_META) % CHUNK
N_POOL_LAYERS = (DEPTH + 1) // 2
N_HGRN_LAYERS = DEPTH // 2
EPS = 1e-6

kernel_name = "hybrid_pool_hgrn2_meta"


def rmsnorm(x, w):
    x32 = x.astype(jnp.float32)
    y = x32 * lax.rsqrt(jnp.mean(x32 * x32, axis=-1, keepdims=True) + EPS)
    return (y * w.astype(jnp.float32)).astype(x.dtype)


def pool_mixer(h, w_in, w_grp, scale, w_out):
    b_, L, _ = h.shape
    v, gate = jnp.split(h @ w_in, 2, axis=-1)
    v32 = v.astype(jnp.float32)
    cs = jnp.cumsum(v32, axis=1)
    t = jnp.arange(L)
    groups = []
    for g, w in enumerate(POOL_WINDOWS):
        sl = slice(g * POOL_GROUP_DIM, (g + 1) * POOL_GROUP_DIM)
        c = cs[..., sl]
        c_shift = jnp.pad(c, ((0, 0), (w, 0), (0, 0)))[:, :L]
        cnt = jnp.minimum(t + 1, w).astype(jnp.float32)[None, :, None]
        groups.append((c - c_shift) / cnt - v32[..., sl])
    u = jnp.stack(groups, axis=2).astype(h.dtype)
    u = jnp.einsum('blgc,gcd->blgd', u, w_grp).reshape(b_, L, E_POOL) * scale
    return (u * jax.nn.silu(gate)) @ w_out


def _hgrn_chunk_step(S, xs):
    q, k, v, g = xs
    c = q.shape[2]
    causal = jnp.tril(jnp.ones((c, c), dtype=bool))
    bcum = jnp.cumsum(g, axis=2)
    rel = bcum[:, :, :, None, :] - bcum[:, :, None, :, :]
    decay = jnp.exp(jnp.where(causal[:, :, None], rel, -jnp.inf))
    scores = jnp.einsum('bhtk,bhsk,bhtsk->bhts', q, k, decay)
    o = jnp.einsum('bhts,bhsv->bhtv', scores, v) \
        + jnp.einsum('bhtk,bhkv->bhtv', q * jnp.exp(bcum), S)
    b_end = bcum[:, :, -1, :]
    S_new = jnp.exp(b_end)[..., None] * S \
        + jnp.einsum('bhsk,bhsv->bhkv', k * jnp.exp(b_end[:, :, None, :] - bcum), v)
    return S_new, o


def hgrn2_mixer(h, w_in, lb, o_norm, w_out):
    b_, L, _ = h.shape
    q, fp, i_in, gate = jnp.split(h @ w_in, 4, axis=-1)
    q = jax.nn.silu(q)
    fp32 = fp.astype(jnp.float32)
    lb32 = lb.astype(jnp.float32)
    f = lb32 + (1.0 - lb32) * jax.nn.sigmoid(fp32)
    log_f = jnp.log(f)
    k = (1.0 - lb32) * jax.nn.sigmoid(-fp32)

    def to_chunks(a):
        a = jnp.pad(a.astype(jnp.float32), ((0, 0), (PAD_FRONT, 0), (0, 0)))
        n = a.shape[1] // CHUNK
        return a.reshape(b_, n, CHUNK, N_HGRN_HEADS, HGRN_HEAD_DIM).transpose(1, 0, 3, 2, 4)

    xs = (to_chunks(q), to_chunks(k), to_chunks(i_in), to_chunks(log_f))
    S0 = jnp.zeros((b_, N_HGRN_HEADS, HGRN_HEAD_DIM, HGRN_HEAD_DIM), jnp.float32)
    _, o = lax.scan(_hgrn_chunk_step, S0, xs)
    n = o.shape[0]
    o = o.transpose(1, 0, 3, 2, 4).reshape(b_, n * CHUNK, N_HGRN_HEADS, HGRN_HEAD_DIM)[:, PAD_FRONT:]
    o = o * lax.rsqrt(jnp.mean(o * o, axis=-1, keepdims=True) + EPS)
    o = o.reshape(b_, L, E_HGRN) * o_norm.astype(jnp.float32)
    return (o.astype(h.dtype) * jax.nn.silu(gate)) @ w_out


def setup_inputs(seed: int = 0) -> dict:
    key = jax.random.key(seed)
    ks = jax.random.split(key, 12)
    nrm = jax.random.normal
    f32 = jnp.float32
    return {
        "x": nrm(ks[0], (BATCH, SEQ, D_MODEL), f32),
        "meta_tokens": nrm(ks[1], (N_META, D_MODEL), f32),
        "norm_w": 1.0 + 0.05 * nrm(ks[2], (DEPTH, D_MODEL), f32),
        "pool_w_in": nrm(ks[3], (N_POOL_LAYERS, D_MODEL, 2 * E_POOL), f32) * D_MODEL ** -0.5,
        "pool_w_grp": nrm(ks[4], (N_POOL_LAYERS, N_POOL_GROUPS, POOL_GROUP_DIM, POOL_GROUP_DIM), f32) * POOL_GROUP_DIM ** -0.5,
        "pool_scale": 1.0 + 0.1 * nrm(ks[5], (N_POOL_LAYERS, E_POOL), f32),
        "pool_w_out": nrm(ks[6], (N_POOL_LAYERS, E_POOL, D_MODEL), f32) * E_POOL ** -0.5,
        "hgrn_w_in": nrm(ks[7], (N_HGRN_LAYERS, D_MODEL, 4 * E_HGRN), f32) * D_MODEL ** -0.5,
        "hgrn_lb_logits": 1.0 + 0.5 * nrm(ks[8], (DEPTH, E_HGRN), f32),
        "hgrn_o_norm": 1.0 + 0.05 * nrm(ks[9], (N_HGRN_LAYERS, E_HGRN), f32),
        "hgrn_w_out": nrm(ks[10], (N_HGRN_LAYERS, E_HGRN, D_MODEL), f32) * E_HGRN ** -0.5,
        "final_norm_w": 1.0 + 0.05 * nrm(ks[11], (D_MODEL,), f32),
    }


def reference(x, meta_tokens, norm_w, pool_w_in, pool_w_grp, pool_scale, pool_w_out,
              hgrn_w_in, hgrn_lb_logits, hgrn_o_norm, hgrn_w_out, final_norm_w):
    b_ = x.shape[0]
    meta = jnp.broadcast_to(meta_tokens.astype(x.dtype)[None], (b_, N_META, x.shape[-1]))
    h = jnp.concatenate([meta, x], axis=1)
    p = jax.nn.softmax(hgrn_lb_logits.astype(jnp.float32), axis=0)
    lb_all = jnp.cumsum(p, axis=0) - p[0]
    for i in range(DEPTH):
        hn = rmsnorm(h, norm_w[i])
        j = i // N_MIXERS
        if i % N_MIXERS == 0:
            y = pool_mixer(hn, pool_w_in[j], pool_w_grp[j], pool_scale[j], pool_w_out[j])
        else:
            y = hgrn2_mixer(hn, hgrn_w_in[j], lb_all[i], hgrn_o_norm[j], hgrn_w_out[j])
        h = h + y
    return rmsnorm(h[:, N_META:], final_norm_w)
```

```cpp
#include <hip/hip_runtime.h>
#include <cstdio>
#include <cstdint>

#define LAS __attribute__((address_space(3)))
#define GAS __attribute__((address_space(1)))
typedef unsigned short bf16_t;
typedef short bf16x8 __attribute__((ext_vector_type(8)));
typedef float f32x4 __attribute__((ext_vector_type(4)));
typedef float f32x2 __attribute__((ext_vector_type(2)));
typedef unsigned u32x4 __attribute__((ext_vector_type(4)));
typedef unsigned u32x2 __attribute__((ext_vector_type(2)));

constexpr int BATCH = 4, SEQ = 8192, DM = 1024, MROWS = BATCH * SEQ, EW = 2048, NMETA = 16, NHEAD = 16, HD = 128;
constexpr float EPS = 1e-6f;
constexpr int NWAVES = 8;

__device__ __forceinline__ unsigned f2bf(float f) { unsigned u = __builtin_bit_cast(unsigned, f); return (u + 0x7fffu + ((u >> 16) & 1u)) >> 16; }
__device__ __forceinline__ unsigned pk2(float lo, float hi) { return f2bf(lo) | (f2bf(hi) << 16); }
__device__ __forceinline__ float bf_lo(unsigned w) { return __builtin_bit_cast(float, w << 16); }
__device__ __forceinline__ float bf_hi(unsigned w) { return __builtin_bit_cast(float, w & 0xffff0000u); }
__device__ __forceinline__ float fast_sigmoid(float x) { return __builtin_amdgcn_rcpf(1.0f + __builtin_amdgcn_exp2f(-1.44269504089f * x)); }
__device__ __forceinline__ float fast_silu(float x) { return x * fast_sigmoid(x); }
__device__ __forceinline__ float fast_exp(float x) { return __builtin_amdgcn_exp2f(1.44269504089f * x); }

namespace pg8 {
#define PG8_LAS __attribute__((address_space(3)))
constexpr int BM = 256, BK = 64, HALF = 128, HTB = HALF * BK * 2  , STAGE_BYTES = 8 * HTB, NXCD = 8, WGM = 8;

__host__ __device__ __forceinline__ int lds_byte(int r, int c) { const int st = (r >> 4) * 2 + (c >> 5), rr = r & 15, cc = c & 31, ob = rr * 64 + cc * 2; return st * 1024 + (ob ^ (((ob >> 9) & 1) << 5)); }
__host__ __device__ __forceinline__ void stage_rc(int b, int& R, int& C) { const int st = b / 1024, sb = b % 1024, swz = sb ^ (((sb >> 9) & 1) << 5); R = (st >> 1) * 16 + swz / 64; C = (st & 1) * 32 + (swz % 64) / 2; }
__host__ __device__ __forceinline__ int perm32(int rho) { const int n = rho >> 4, i = rho & 15; return 8 * (i >> 2) + 4 * n + (i & 3); }

struct Unit { int pm, pn, g; };
struct Gemm { const bf16_t* A; const bf16_t* Bt; };

struct StaticOrder {
    int nM, nN, nwg, G, c;
    __host__ __device__ void init(int M, int N, int G_, int c_) { nM = M / BM; nN = N / BM; nwg = nM * nN; G = G_; c = c_; }
    __host__ __device__ bool next(int i, Unit& u) const {
        const long L = (long)i * G + c; if (L >= nwg) return false;
        int wgid = (int)L; { const int q = nwg / NXCD, r = nwg % NXCD, xcd = wgid % NXCD, off = wgid / NXCD; wgid = (xcd < r ? xcd * (q + 1) : r * (q + 1) + (xcd - r) * q) + off; }
        const int nig = WGM * nN, gid = wgid / nig, fm = gid * WGM, gsz = (nM - fm) < WGM ? (nM - fm) : WGM;
        u.pm = fm + ((wgid % nig) % gsz); u.pn = (wgid % nig) / gsz; u.g = 0; return true;
    }
    __device__ __forceinline__ void a_ready(const Unit&) const {}
    __device__ __forceinline__ void done(const Unit&) const {}
};
struct GroupOrder {
    int nM, nN, ngrp, G, c;
    __host__ __device__ bool next(int i, Unit& u) const {
        const long L = (long)i * G + c; if (L >= (long)nM * nN * ngrp) return false;
        const int per = nM * nN; u.g = (int)L / per; const int r = (int)L % per; u.pm = r / nN; u.pn = r % nN; return true;
    }
    __device__ __forceinline__ void a_ready(const Unit&) const {}
    __device__ __forceinline__ void done(const Unit&) const {}
};

__device__ __forceinline__ unsigned cvt_pk_bf16(float lo, float hi) { unsigned r; asm volatile("v_cvt_pk_bf16_f32 %0, %1, %2" : "=v"(r) : "v"(lo), "v"(hi)); return r; }

template <class Epi, class Sched, bool ALIGN_EPI, bool SP2, int KK, int LDA, int LDB, int GA = 0, int GB = 0>
__device__ __forceinline__ void gemm_phase(PG8_LAS unsigned char* lds, const Gemm g, const Sched& S, const Epi& E) {
    const int tid = threadIdx.x, wid = __builtin_amdgcn_readfirstlane(tid >> 6), lane = tid & 63, wr = wid >> 2, wc = wid & 3, fr = lane & 15, fq = lane >> 4;
    constexpr int K = KK, nt = K / BK;
    unsigned voffA[2], voffB[2];
#pragma unroll
    for (int i = 0; i < 2; ++i) { int R, C; stage_rc(tid * 16 + i * 8192, R, C); const int Rb = Epi::PERM ? ((R & ~31) + perm32(R & 31)) : R;
        voffA[i] = (unsigned)(R * LDA + C) * 2u; voffB[i] = (unsigned)(Rb * LDB + C) * 2u; }
    const size_t kstep = (size_t)(BK * 2);
    const size_t hstepA = (size_t)HALF * LDA * 2, hstepB = (size_t)HALF * LDB * 2;
    const size_t tstepA = 2 * hstepA, tstepB = 2 * hstepB;
    const unsigned ldsw = (unsigned)wid * 1024u;
    const int aoff = lds_byte(wr * 64 + fr, fq * 8), boff = lds_byte(wc * 32 + fr, fq * 8);
#define PG8_SA(b, h) (((b) * 2 + (h)) * HTB)
#define PG8_SB(b, h) ((4 + (b) * 2 + (h)) * HTB)
#define PG8_STAGE(bufoff, gbase, voff) do { _Pragma("unroll") for (int _i = 0; _i < 2; ++_i) \
        __builtin_amdgcn_global_load_lds((const unsigned*)((const char*)(gbase) + (voff)[_i]), (PG8_LAS unsigned*)(lds + (bufoff) + ldsw + _i * 8192), 16, 0, 0); } while (0)
#define PG8_LDA(dst, b, h) do { _Pragma("unroll") for (int m = 0; m < 4; ++m) _Pragma("unroll") for (int k = 0; k < 2; ++k) dst[m][k] = *(const PG8_LAS bf16x8*)(lds + PG8_SA(b, h) + aoff + m * 2048 + k * 1024); } while (0)
#define PG8_LDB(dst, b, h) do { _Pragma("unroll") for (int n = 0; n < 2; ++n) _Pragma("unroll") for (int k = 0; k < 2; ++k) dst[n][k] = *(const PG8_LAS bf16x8*)(lds + PG8_SB(b, h) + boff + n * 2048 + k * 1024); } while (0)
#define PG8_MMA(ai, bj, At, Bt) do { __builtin_amdgcn_s_setprio(1); _Pragma("unroll") for (int m = 0; m < 4; ++m) _Pragma("unroll") for (int n = 0; n < 2; ++n) _Pragma("unroll") for (int k = 0; k < 2; ++k) \
        acc[ai][bj][m][n] = __builtin_amdgcn_mfma_f32_16x16x32_bf16(Bt[n][k], At[m][k], acc[ai][bj][m][n], 0, 0, 0); __builtin_amdgcn_s_setprio(0); } while (0)
#define PG8_WAIT_V(n) asm volatile("s_waitcnt vmcnt(" #n ")" ::: "memory")
#define PG8_WAIT_L(n) asm volatile("s_waitcnt lgkmcnt(" #n ")" ::: "memory")
#define PG8_BAR __builtin_amdgcn_s_barrier()
#define PG8_SCHED __builtin_amdgcn_sched_barrier(0)
    Unit cur, nxt; int ui = 0;
    if (!S.next(0, cur)) return;
    f32x4 acc[2][2][4][2];
#pragma unroll
    for (int a = 0; a < 2; ++a)
#pragma unroll
        for (int b = 0; b < 2; ++b)
#pragma unroll
            for (int m = 0; m < 4; ++m)
#pragma unroll
                for (int n = 0; n < 2; ++n) acc[a][b][m][n] = (f32x4){0.f, 0.f, 0.f, 0.f};
    bf16x8 At[4][2], B0[2][2], B1[2][2];
    const char* cA = (const char*)g.A + (size_t)cur.g * (size_t)GA * 2 + (size_t)cur.pm * tstepA; const char* cB = (const char*)g.Bt + (size_t)cur.g * (size_t)GB * 2 + (size_t)cur.pn * tstepB;
    S.a_ready(cur);
    if constexpr (SP2) {
        PG8_STAGE(PG8_SB(0, 0), cB, voffB); PG8_STAGE(PG8_SB(0, 1), cB + hstepB, voffB); PG8_STAGE(PG8_SA(0, 0), cA, voffA); PG8_STAGE(PG8_SA(0, 1), cA + hstepA, voffA);
        if (wr == 1) PG8_BAR;
        PG8_WAIT_V(2); PG8_BAR;
        PG8_STAGE(PG8_SB(1, 0), cB + kstep, voffB); PG8_STAGE(PG8_SA(1, 0), cA + kstep, voffA); PG8_STAGE(PG8_SB(1, 1), cB + hstepB + kstep, voffB);
        PG8_WAIT_V(6); PG8_BAR;
    } else {
        PG8_STAGE(PG8_SB(0, 0), cB, voffB); PG8_STAGE(PG8_SA(0, 0), cA, voffA); PG8_STAGE(PG8_SB(0, 1), cB + hstepB, voffB); PG8_STAGE(PG8_SA(0, 1), cA + hstepA, voffA);
        if (wr == 1) PG8_BAR;
        PG8_WAIT_V(4); PG8_BAR;
        PG8_STAGE(PG8_SB(1, 0), cB + kstep, voffB); PG8_STAGE(PG8_SA(1, 0), cA + kstep, voffA); PG8_STAGE(PG8_SB(1, 1), cB + hstepB + kstep, voffB);
        PG8_WAIT_V(6); PG8_BAR;
    }
    for (;;) {
        const bool has_next = S.next(ui + 1, nxt);
        const char* nA = has_next ? (const char*)g.A + (size_t)nxt.g * (size_t)GA * 2 + (size_t)nxt.pm * tstepA : cA; const char* nB = has_next ? (const char*)g.Bt + (size_t)nxt.g * (size_t)GB * 2 + (size_t)nxt.pn * tstepB : cB;
        for (int t = 0; t < nt; t += 2) {
            const bool last = (t == nt - 2);
            const char* a1 = cA + (size_t)(t + 1) * kstep;
            const char* a2 = last ? nA : cA + (size_t)(t + 2) * kstep; const char* b2 = last ? nB : cB + (size_t)(t + 2) * kstep;
            const char* a3 = a2 + kstep; const char* b3 = b2 + kstep;
            if (last && has_next) S.a_ready(nxt);
            if constexpr (SP2) {
            PG8_LDB(B0, 0, 0); PG8_LDB(B1, 0, 1); PG8_SCHED; PG8_LDA(At, 0, 0); PG8_STAGE(PG8_SA(1, 1), a1 + hstepA, voffA);
            PG8_WAIT_V(8); PG8_WAIT_L(0); PG8_BAR; PG8_MMA(0, 0, At, B0); PG8_MMA(0, 1, At, B1); PG8_BAR; PG8_SCHED;
            PG8_LDA(At, 0, 1); PG8_STAGE(PG8_SB(0, 0), b2, voffB); PG8_STAGE(PG8_SB(0, 1), b2 + hstepB, voffB); PG8_STAGE(PG8_SA(0, 0), a2, voffA);
            PG8_WAIT_V(8); PG8_WAIT_L(0); PG8_BAR; PG8_MMA(1, 0, At, B0); PG8_MMA(1, 1, At, B1); PG8_BAR; PG8_SCHED;
            PG8_LDB(B0, 1, 0); PG8_LDB(B1, 1, 1); PG8_SCHED; PG8_LDA(At, 1, 0); PG8_STAGE(PG8_SA(0, 1), a2 + hstepA, voffA);
            PG8_WAIT_V(8); PG8_WAIT_L(0); PG8_BAR; PG8_MMA(0, 0, At, B0); PG8_MMA(0, 1, At, B1); PG8_BAR; PG8_SCHED;
            PG8_LDA(At, 1, 1); PG8_STAGE(PG8_SB(1, 0), b3, voffB); PG8_STAGE(PG8_SB(1, 1), b3 + hstepB, voffB); PG8_STAGE(PG8_SA(1, 0), a3, voffA);
            PG8_WAIT_V(8); PG8_WAIT_L(0); PG8_BAR; PG8_MMA(1, 0, At, B0); PG8_MMA(1, 1, At, B1); PG8_BAR; PG8_SCHED;
            } else {
            PG8_LDB(B0, 0, 0); PG8_SCHED; PG8_LDA(At, 0, 0); PG8_STAGE(PG8_SA(1, 1), a1 + hstepA, voffA);
            PG8_WAIT_L(8); PG8_BAR; PG8_WAIT_L(0); PG8_MMA(0, 0, At, B0); PG8_BAR; PG8_SCHED;
            PG8_LDB(B1, 0, 1); PG8_STAGE(PG8_SB(0, 0), b2, voffB);
            PG8_BAR; PG8_WAIT_L(0); PG8_MMA(0, 1, At, B1); PG8_BAR;
            PG8_LDA(At, 0, 1); PG8_STAGE(PG8_SA(0, 0), a2, voffA);
            PG8_BAR; PG8_WAIT_L(0); PG8_MMA(1, 0, At, B0); PG8_BAR; PG8_SCHED;
            PG8_STAGE(PG8_SB(0, 1), b2 + hstepB, voffB);
            PG8_WAIT_V(6); PG8_BAR; PG8_MMA(1, 1, At, B1); PG8_BAR;
            PG8_LDB(B0, 1, 0); PG8_SCHED; PG8_LDA(At, 1, 0); PG8_STAGE(PG8_SA(0, 1), a2 + hstepA, voffA);
            PG8_WAIT_L(8); PG8_BAR; PG8_WAIT_L(0); PG8_MMA(0, 0, At, B0); PG8_BAR; PG8_SCHED;
            PG8_LDB(B1, 1, 1); PG8_STAGE(PG8_SB(1, 0), b3, voffB);
            PG8_BAR; PG8_WAIT_L(0); PG8_MMA(0, 1, At, B1); PG8_BAR;
            PG8_LDA(At, 1, 1); PG8_STAGE(PG8_SA(1, 0), a3, voffA);
            PG8_BAR; PG8_WAIT_L(0); PG8_MMA(1, 0, At, B0); PG8_BAR; PG8_SCHED;
            PG8_STAGE(PG8_SB(1, 1), b3 + hstepB, voffB);
            PG8_WAIT_V(6); PG8_BAR; PG8_MMA(1, 1, At, B1); PG8_BAR;
            }
        }
        if constexpr (ALIGN_EPI) { if (wr == 0) PG8_BAR; }
        if constexpr (!Epi::AFTER_DRAIN) { E(acc, cur, wr, wc, fr, fq); S.done(cur); }
        if (!has_next) break;
#pragma unroll
        for (int a = 0; a < 2; ++a)
#pragma unroll
            for (int b = 0; b < 2; ++b)
#pragma unroll
                for (int m = 0; m < 4; ++m)
#pragma unroll
                    for (int n = 0; n < 2; ++n) acc[a][b][m][n] = (f32x4){0.f, 0.f, 0.f, 0.f};
        cur = nxt; cA = nA; cB = nB; ++ui;
        if constexpr (ALIGN_EPI) { if (wr == 1) PG8_BAR; }
    }
    PG8_WAIT_V(0);
    if constexpr (!ALIGN_EPI) { if (wr == 0) PG8_BAR; }
    PG8_BAR;
    if constexpr (Epi::AFTER_DRAIN) { E.fused(acc, cur, wr, wc, fr, fq, lds, wid, lane); S.done(cur); }
#undef PG8_SA
#undef PG8_SB
#undef PG8_STAGE
#undef PG8_LDA
#undef PG8_LDB
#undef PG8_MMA
#undef PG8_WAIT_V
#undef PG8_WAIT_L
#undef PG8_BAR
#undef PG8_SCHED
}

struct EpiBf16Plain {
    static constexpr bool PERM = true, AFTER_DRAIN = false;
    bf16_t* O; int ldc; size_t gO; int split_cols; size_t split_stride;
    __device__ __forceinline__ void operator()(const f32x4 (&acc)[2][2][4][2], const Unit& u, int wr, int wc, int fr, int fq) const {
        const int row0 = u.pm * BM + wr * 64 + fr; int colt = u.pn * BM; bf16_t* base = O + (size_t)u.g * gO;
        if (split_cols) { const int t = colt / split_cols; base += (size_t)t * split_stride; colt -= t * split_cols; }
        const int col0 = colt + wc * 32 + 8 * fq;
#pragma unroll
        for (int ai = 0; ai < 2; ++ai)
#pragma unroll
            for (int m = 0; m < 4; ++m) { bf16_t* rowp = base + (size_t)(row0 + ai * HALF + m * 16) * ldc + col0;
#pragma unroll
                for (int bj = 0; bj < 2; ++bj) { const f32x4 v0 = acc[ai][bj][m][0], v1 = acc[ai][bj][m][1];
                    u32x4 w; w.x = cvt_pk_bf16(v0[0], v0[1]); w.y = cvt_pk_bf16(v0[2], v0[3]); w.z = cvt_pk_bf16(v1[0], v1[1]); w.w = cvt_pk_bf16(v1[2], v1[3]);
                    *(u32x4*)(rowp + bj * HALF) = w; } }
    }
};
struct EpiResid {
    static constexpr bool PERM = true, AFTER_DRAIN = false;
    const float* base; float* out; bf16_t* ob; float* ssq;
    __device__ __forceinline__ void operator()(const f32x4 (&acc)[2][2][4][2], const Unit& u, int wr, int wc, int fr, int fq) const {
        const int row0 = u.pm * BM + wr * 64 + fr, col0 = u.pn * BM + wc * 32 + 8 * fq;
#pragma unroll
        for (int ai = 0; ai < 2; ++ai)
#pragma unroll
            for (int m = 0; m < 4; ++m) { const int r = row0 + ai * HALF + m * 16; const size_t off = (size_t)r * DM + col0; float s = 0.f;
#pragma unroll
                for (int bj = 0; bj < 2; ++bj) {
                    const f32x4 b0 = *(const f32x4*)(base + off + bj * HALF), b1 = *(const f32x4*)(base + off + bj * HALF + 4);
                    const f32x4 v0 = acc[ai][bj][m][0] + b0, v1 = acc[ai][bj][m][1] + b1;
                    *(f32x4*)(out + off + bj * HALF) = v0; *(f32x4*)(out + off + bj * HALF + 4) = v1;
                    if (ob) { u32x4 w; w.x = cvt_pk_bf16(v0[0], v0[1]); w.y = cvt_pk_bf16(v0[2], v0[3]); w.z = cvt_pk_bf16(v1[0], v1[1]); w.w = cvt_pk_bf16(v1[2], v1[3]); *(u32x4*)(ob + off + bj * HALF) = w; }
                    s += (v0[0] * v0[0] + v0[1] * v0[1]) + (v0[2] * v0[2] + v0[3] * v0[3]) + (v1[0] * v1[0] + v1[1] * v1[1]) + (v1[2] * v1[2] + v1[3] * v1[3]); }
                if (ssq) { s += __shfl_xor(s, 16); s += __shfl_xor(s, 32); if (fq == 0) atomicAdd(ssq + r, s); } }
    }
};
struct EpiHgrn {
    static constexpr bool PERM = true, AFTER_DRAIN = false;
    const float* ssq1; const float* lb; bf16_t* Q; size_t pstride;
    __device__ __forceinline__ void operator()(const f32x4 (&acc)[2][2][4][2], const Unit& u, int wr, int wc, int fr, int fq) const {
        const int part = u.pn >> 3, colt = (u.pn & 7) * BM;
        bf16_t* O = Q + (size_t)part * pstride;
        const int row0 = u.pm * BM + wr * 64 + fr, col0 = colt + wc * 32 + 8 * fq;
        f32x4 lbv[2][2];
#pragma unroll
        for (int bj = 0; bj < 2; ++bj)
#pragma unroll
            for (int n = 0; n < 2; ++n) lbv[bj][n] = *(const f32x4*)(lb + col0 + bj * HALF + 4 * n);
#pragma unroll
        for (int ai = 0; ai < 2; ++ai)
#pragma unroll
            for (int m = 0; m < 4; ++m) { const int r = row0 + ai * HALF + m * 16; const float rs = __builtin_amdgcn_rsqf(ssq1[r] * (1.0f / DM) + EPS);
                bf16_t* rowp = O + (size_t)r * EW + col0;
#pragma unroll
                for (int bj = 0; bj < 2; ++bj) { float x[8];
#pragma unroll
                    for (int e = 0; e < 8; ++e) { const float a = acc[ai][bj][m][e >> 2][e & 3] * rs;
                        if (part == 0) x[e] = fast_silu(a);
                        else if (part == 1) { const float l = lbv[bj][e >> 2][e & 3]; const float f = l + (1.0f - l) * fast_sigmoid(a); x[e] = 0.69314718056f * __builtin_amdgcn_logf(f); }
                        else x[e] = a; }
                    u32x4 w; w.x = cvt_pk_bf16(x[0], x[1]); w.y = cvt_pk_bf16(x[2], x[3]); w.z = cvt_pk_bf16(x[4], x[5]); w.w = cvt_pk_bf16(x[6], x[7]);
                    *(u32x4*)(rowp + bj * HALF) = w; } }
    }
};
struct EpiGate {
    static constexpr bool PERM = true, AFTER_DRAIN = false;
    const float* ssq1; const float* ssqh; const float* onorm; bf16_t* O;
    __device__ __forceinline__ void operator()(const f32x4 (&acc)[2][2][4][2], const Unit& u, int wr, int wc, int fr, int fq) const {
        const int row0 = u.pm * BM + wr * 64 + fr, col0 = u.pn * BM + wc * 32 + 8 * fq;
        f32x4 onv[2][2];
#pragma unroll
        for (int bj = 0; bj < 2; ++bj)
#pragma unroll
            for (int n = 0; n < 2; ++n) onv[bj][n] = *(const f32x4*)(onorm + col0 + bj * HALF + 4 * n);
#pragma unroll
        for (int ai = 0; ai < 2; ++ai)
#pragma unroll
            for (int m = 0; m < 4; ++m) { const int r = row0 + ai * HALF + m * 16; const float rs = __builtin_amdgcn_rsqf(ssq1[r] * (1.0f / DM) + EPS);
                bf16_t* rowp = O + (size_t)r * EW + col0;
#pragma unroll
                for (int bj = 0; bj < 2; ++bj) { const float rh = __builtin_amdgcn_rsqf(ssqh[(size_t)r * NHEAD + 2 * u.pn + bj] * (1.0f / HD) + EPS);
                    const u32x4 ov = *(const u32x4*)(rowp + bj * HALF); float x[8];
#pragma unroll
                    for (int e = 0; e < 8; ++e) { const unsigned wv = ov[e >> 1]; const float o = (e & 1) ? bf_hi(wv) : bf_lo(wv);
                        const float gt = fast_silu(acc[ai][bj][m][e >> 2][e & 3] * rs);
                        x[e] = o * rh * onv[bj][e >> 2][e & 3] * gt; }
                    u32x4 w; w.x = cvt_pk_bf16(x[0], x[1]); w.y = cvt_pk_bf16(x[2], x[3]); w.z = cvt_pk_bf16(x[4], x[5]); w.w = cvt_pk_bf16(x[6], x[7]);
                    *(u32x4*)(rowp + bj * HALF) = w; } }
    }
};
}

#ifndef MK_N_LAUNCHES
#define MK_N_LAUNCHES 0
#endif
constexpr int N_PHASES = 10;

constexpr size_t MiB = 1u << 20, KiB = 1u << 10;
constexpr size_t WS_CTL = 0, CTL_ZERO_BYTES = 1 * MiB;
constexpr size_t WS_SSQ1 = 256 * KiB;
constexpr size_t WS_W1T = 1 * MiB;
constexpr size_t WS_WGT = 9 * MiB;
constexpr size_t WS_WINV = 11 * MiB;
constexpr size_t WS_WO0T = 15 * MiB;
constexpr size_t WS_HWIN = 19 * MiB;
constexpr size_t WS_HWOUT = 35 * MiB;
constexpr size_t WS_SMALL = 39 * MiB;
constexpr size_t WS_LB = WS_SMALL;
constexpr size_t WS_VGM = WS_SMALL + 320 * KiB;
constexpr size_t WS_ZM = WS_SMALL + 576 * KiB;
constexpr size_t WS_ZMB = WS_SMALL + 1152 * KiB;
constexpr size_t WS_A2M = WS_SMALL + 704 * KiB;
constexpr size_t WS_H1M = WS_SMALL + 832 * KiB;
constexpr size_t WS_FM = WS_SMALL + 896 * KiB;
constexpr size_t WS_IM = WS_SMALL + 1024 * KiB;
constexpr size_t WS_SMETA = WS_SMALL + 2048 * KiB;
constexpr size_t WS_SSQH = 43 * MiB;
constexpr size_t WS_XN0 = 45 * MiB;
constexpr size_t WS_Z = 109 * MiB;
constexpr size_t WS_GATE = 237 * MiB;
constexpr size_t WS_A2 = 365 * MiB;
constexpr size_t WS_END = 493 * MiB;
constexpr int CW_TMO = 0, CW_CODE = 1, CW_BAR = 4096;

constexpr int RING_OFF = 0, RING_BYTES = 131072;
constexpr int LDSCTL_OFF = RING_BYTES, MISC_OFF = LDSCTL_OFF + 320;
constexpr int RED_OFF = 132 * 1024;
constexpr int RS_OFF = 140 * 1024;
constexpr int LDS_BYTES = 147456;

typedef GAS unsigned gu32;
#define RLX_AGENT __ATOMIC_RELAXED, __HIP_MEMORY_SCOPE_AGENT
#define LDS_WAIT() asm volatile("s_waitcnt lgkmcnt(0)" ::: "memory")
#define VM_WAIT() asm volatile("s_waitcnt vmcnt(0)" ::: "memory")

#define XB_TMO      128
#define XB_XCNT(j)  (256  + 64 * (j))
#define XB_XSUB(j)  (1280 + 64 * (j))
#define XB_XGEN(j)  (2304 + 64 * (j))
#define XB_TOP      3328
#define XB_TOPGEN   3392
#define XCD_BAR_WORDS 3456
#define XB_SPIN_CAP (1u << 18)

__device__ __forceinline__ unsigned xb_ld(unsigned* p)              { return __hip_atomic_load(p, __ATOMIC_RELAXED, __HIP_MEMORY_SCOPE_AGENT); }
__device__ __forceinline__ unsigned xb_add(unsigned* p, unsigned v) { return __hip_atomic_fetch_add(p, v, __ATOMIC_RELAXED, __HIP_MEMORY_SCOPE_AGENT); }
__device__ __forceinline__ unsigned xb_xcc_id() { return (unsigned)__builtin_amdgcn_s_getreg((3 << 11) | 20) & 0xFu; }
#define XB_SPIN(cond, bar) do { unsigned _sp = 0; while (cond) { __builtin_amdgcn_s_sleep(1); \
    if ((++_sp & 255u) == 0u) { if (xb_ld(&(bar)[XB_TMO])) break; if (_sp > XB_SPIN_CAP) { atomicAdd(&(bar)[XB_TMO], 1u); break; } } } } while (0)

struct XcdBarrier { unsigned* bar; unsigned x; volatile LAS unsigned* st; };

__device__ __forceinline__ XcdBarrier xcd_barrier_post(unsigned* bar, volatile LAS unsigned* st) {
    XcdBarrier b; b.bar = bar; b.x = xb_xcc_id(); b.st = st;
    if (threadIdx.x == 0) (void)xb_add(&bar[XB_XCNT(b.x)], 1u);
    return b;
}
__device__ __forceinline__ void xcd_barrier_complete(unsigned* bar, unsigned x, unsigned& nloc, unsigned& nx) {
    const unsigned G = gridDim.x * gridDim.y * gridDim.z;
    unsigned sum, cnt, mine, sp = 0u;
    for (;;) {
        sum = 0u; cnt = 0u; mine = 0u;
#pragma unroll
        for (unsigned j = 0; j < 16; ++j) { const unsigned c = xb_ld(&bar[XB_XCNT(j)]); sum += c; cnt += (c > 0u) ? 1u : 0u; mine = (j == x) ? c : mine; }
        if (sum == G) break;
        __builtin_amdgcn_s_sleep(1);
        if ((++sp & 255u) == 0u) { if (xb_ld(&bar[XB_TMO])) break; if (sp > XB_SPIN_CAP) { atomicAdd(&bar[XB_TMO], 1u); break; } }
    }
    nloc = mine > 0u ? mine : 1u; nx = cnt > 0u ? cnt : 1u;
}
__device__ __forceinline__ void xcd_barrier(const XcdBarrier& b) {
    asm volatile("s_waitcnt vmcnt(0)" ::: "memory");
    __syncthreads();
    if (threadIdx.x == 0) {
        unsigned* bar = b.bar;
        __builtin_amdgcn_s_waitcnt(0);
        unsigned nloc = b.st[0], nx = b.st[1];
        if (nloc == 0u) { xcd_barrier_complete(bar, b.x, nloc, nx); b.st[0] = nloc; b.st[1] = nx; }
        const unsigned old = xb_add(&bar[XB_XSUB(b.x)], 1u);
        const unsigned gen = old / nloc;
        if (old + 1u == (gen + 1u) * nloc) {
            __builtin_amdgcn_fence(__ATOMIC_RELEASE, "agent");
            asm volatile("s_waitcnt vmcnt(0)" ::: "memory");
            const unsigned og = xb_add(&bar[XB_TOP], 1u);
            const unsigned tg = og / nx;
            if (og + 1u == (tg + 1u) * nx) xb_add(&bar[XB_TOPGEN], 1u);
            else XB_SPIN(xb_ld(&bar[XB_TOPGEN]) == tg, bar);
            __builtin_amdgcn_fence(__ATOMIC_ACQUIRE, "agent");
            xb_add(&bar[XB_XGEN(b.x)], 1u);
            asm volatile("s_waitcnt vmcnt(0)" ::: "memory");
        } else {
            XB_SPIN(xb_ld(&bar[XB_XGEN(b.x)]) == gen, bar);
            __builtin_amdgcn_fence(__ATOMIC_ACQUIRE, "agent");
            asm volatile("s_waitcnt vmcnt(0)" ::: "memory");
        }
    }
    __syncthreads();
}

struct Frame {
    LAS unsigned char* lds;
    volatile LAS unsigned* MISC;
    gu32* ctl;
    int tid, lane, wave;
    int vcu, G;
    const float *x, *meta, *normw, *pwin, *pwgrp, *pscale, *pwout, *hwin, *hlb, *honorm, *hwout, *fnw;
    float* out;
    unsigned char* ws;
};
__device__ __forceinline__ float wave_sum(float v) {
#pragma unroll
    for (int o = 1; o < 64; o <<= 1) v += __shfl_xor(v, o);
    return v;
}

__device__ __forceinline__ void p0_transpose_item(const float* W, int ldw, int col0, int K, int Nsub, bf16_t* WT, int row_off, const float* kscale, LAS float* scr, int item, int lane) {
    const int nblk = Nsub / 32, kb = item / nblk, nb = item % nblk, k0 = 64 * kb, n0 = 32 * nb;
#pragma unroll 8
    for (int i = 0; i < 32; ++i) { const int kk = 2 * i + (lane >> 5); float v = W[(size_t)(k0 + kk) * ldw + col0 + n0 + (lane & 31)]; if (kscale) v *= kscale[k0 + kk]; scr[kk * 33 + (lane & 31)] = v; }
    LDS_WAIT(); asm volatile("" ::: "memory");
    const int c = lane & 7;
#pragma unroll
    for (int j = 0; j < 4; ++j) { const int n = (lane >> 3) + 8 * j; const LAS float* s = scr + (8 * c) * 33 + n;
        u32x4 o; o.x = pk2(s[0 * 33], s[1 * 33]); o.y = pk2(s[2 * 33], s[3 * 33]); o.z = pk2(s[4 * 33], s[5 * 33]); o.w = pk2(s[6 * 33], s[7 * 33]);
        *(GAS u32x4*)(WT + (size_t)(row_off + n0 + n) * K + k0 + 8 * c) = o; }
    LDS_WAIT(); asm volatile("" ::: "memory");
}
__device__ __forceinline__ void rms_row_to_bf16(int lane, const float* xrow, const float* w, bf16_t* orow) {
    const GAS f32x4* xr = (const GAS f32x4*)xrow + lane; const GAS f32x4* wr = (const GAS f32x4*)w + lane;
    f32x4 v[4]; float s = 0.f;
#pragma unroll
    for (int j = 0; j < 4; ++j) { v[j] = xr[64 * j]; s += (v[j].x * v[j].x + v[j].y * v[j].y) + (v[j].z * v[j].z + v[j].w * v[j].w); }
    const float rstd = 1.f / sqrtf(wave_sum(s) * (1.f / DM) + EPS);
    GAS unsigned long long* o8 = (GAS unsigned long long*)orow + lane;
#pragma unroll
    for (int j = 0; j < 4; ++j) { const f32x4 ww = wr[64 * j];
        o8[64 * j] = (unsigned long long)pk2(v[j].x * rstd * ww.x, v[j].y * rstd * ww.y) | ((unsigned long long)pk2(v[j].z * rstd * ww.z, v[j].w * rstd * ww.w) << 32); }
}

__device__ __forceinline__ float mini_gemm16(Frame& F, int K, const float* W, int ldw, int ncol) {
    const LAS float* AT = (const LAS float*)(F.lds + RING_OFF); LAS float* red = (LAS float*)(F.lds + RED_OFF);
    const int ks = F.tid >> 4;
    float acc[16];
#pragma unroll
    for (int r = 0; r < 16; ++r) acc[r] = 0.f;
    for (int k = ks; k < K; k += 32) { const float w = W[(size_t)k * ldw + ncol];
        const LAS f32x4* a = (const LAS f32x4*)(AT + k * 16);
#pragma unroll
        for (int q = 0; q < 4; ++q) { const f32x4 av = a[q]; acc[4 * q + 0] += w * av.x; acc[4 * q + 1] += w * av.y; acc[4 * q + 2] += w * av.z; acc[4 * q + 3] += w * av.w; } }
#pragma unroll
    for (int r = 0; r < 16; ++r) { acc[r] += __shfl_xor(acc[r], 16); acc[r] += __shfl_xor(acc[r], 32); }
    if (F.lane < 16) {
#pragma unroll
        for (int r = 0; r < 16; ++r) red[(F.wave * 16 + r) * 16 + F.lane] = acc[r]; }
    __syncthreads();
    float res = 0.f;
    if (F.tid < 256) {
#pragma unroll
        for (int w = 0; w < 8; ++w) res += red[(w * 16 + (F.tid >> 4)) * 16 + (F.tid & 15)]; }
    __syncthreads();
    return res;
}

__device__ __forceinline__ void meta_a(Frame& F) {
    LAS float* rsl = (LAS float*)(F.lds + RS_OFF); LAS float* AT = (LAS float*)(F.lds + RING_OFF);
    for (int r = F.wave; r < 16; r += NWAVES) { float s = 0.f;
        for (int k = F.lane; k < DM; k += 64) { const float v = F.meta[r * DM + k]; s += v * v; }
        s = wave_sum(s); if (F.lane == 0) rsl[r] = 1.f / sqrtf(s * (1.f / DM) + EPS); }
    __syncthreads();
    for (int i = F.tid; i < 16 * DM; i += NWAVES * 64) { const int r = i >> 10, k = i & (DM - 1); AT[k * 16 + r] = F.meta[i] * rsl[r] * F.normw[k]; }
    __syncthreads();
    float* VGM = (float*)(F.ws + WS_VGM);
    for (int bx = F.vcu; bx < 256; bx += F.G) { const int n = bx * 16 + (F.tid & 15);
        const float res = mini_gemm16(F, DM, F.pwin, 4096, n);
        if (F.tid < 256) VGM[(F.tid >> 4) * 4096 + n] = res; }
    __syncthreads();
}
__device__ __forceinline__ void meta_b(Frame& F) {
    LAS float* AT = (LAS float*)(F.lds + RING_OFF); LAS float* zt = (LAS float*)(F.lds + RED_OFF);
    const float* VGM = (const float*)(F.ws + WS_VGM); float* ZM = (float*)(F.ws + WS_ZM); float* A2M = (float*)(F.ws + WS_A2M);
    for (int bx = F.vcu; bx < 128; bx += F.G) { const int g = bx >> 5, n = bx * 16 + (F.tid & 15), d = n & 511;
        for (int i = F.tid; i < 16 * 512; i += NWAVES * 64) { const int r = i >> 9, c = i & 511; AT[c * 16 + r] = VGM[r * 4096 + 512 * g + c]; }
        __syncthreads();
        const float res = mini_gemm16(F, 512, F.pwgrp + (size_t)g * 512 * 512, 512, d);
        if (F.tid < 256) { zt[F.tid] = res; ZM[(F.tid >> 4) * EW + n] = res; ((bf16_t*)(F.ws + WS_ZMB))[(F.tid >> 4) * EW + n] = (bf16_t)f2bf(res); }
        __syncthreads();
        if (F.tid < 256) { const int r = F.tid >> 4, col = F.tid & 15, w = 2 << g, cnt = (r + 1) < w ? (r + 1) : w; float s = 0.f;
            for (int j = 0; j < cnt; ++j) s += zt[(r - j) * 16 + col];
            const float pz = s / (float)cnt - zt[r * 16 + col], gate = VGM[r * 4096 + EW + n];
            A2M[r * EW + n] = pz * F.pscale[n] * (gate / (1.f + expf(-gate))); }
        __syncthreads();
    }
}
__device__ __forceinline__ void meta_c(Frame& F) {
    LAS float* AT = (LAS float*)(F.lds + RING_OFF);
    const float* A2M = (const float*)(F.ws + WS_A2M); float* H1M = (float*)(F.ws + WS_H1M);
    for (int bx = F.vcu; bx < 64; bx += F.G) { const int n = bx * 16 + (F.tid & 15);
        for (int i = F.tid; i < 16 * EW; i += NWAVES * 64) { const int r = i >> 11, c = i & (EW - 1); AT[c * 16 + r] = A2M[i]; }
        __syncthreads();
        const float res = mini_gemm16(F, EW, F.pwout, DM, n);
        if (F.tid < 256) { const int r = F.tid >> 4; H1M[r * DM + n] = F.meta[r * DM + n] + res; }
        __syncthreads();
    }
}
__device__ __forceinline__ void meta_d(Frame& F) {
    LAS float* rsl = (LAS float*)(F.lds + RS_OFF); LAS float* AT = (LAS float*)(F.lds + RING_OFF);
    const float* H1M = (const float*)(F.ws + WS_H1M); const float* LB = (const float*)(F.ws + WS_LB); float* FM = (float*)(F.ws + WS_FM); float* IM = (float*)(F.ws + WS_IM);
    for (int r = F.wave; r < 16; r += NWAVES) { float s = 0.f;
        for (int k = F.lane; k < DM; k += 64) { const float v = H1M[r * DM + k]; s += v * v; }
        s = wave_sum(s); if (F.lane == 0) rsl[r] = 1.f / sqrtf(s * (1.f / DM) + EPS); }
    __syncthreads();
    for (int i = F.tid; i < 16 * DM; i += NWAVES * 64) { const int r = i >> 10, k = i & (DM - 1); AT[k * 16 + r] = H1M[i] * rsl[r] * F.normw[DM + k]; }
    __syncthreads();
    for (int bx = F.vcu; bx < 256; bx += F.G) { const int np = bx * 16 + (F.tid & 15);
        const float res = mini_gemm16(F, DM, F.hwin, 8192, EW + np);
        if (F.tid < 256) { const int r = F.tid >> 4;
            if (np < EW) { const float l = LB[np]; FM[r * EW + np] = l + (1.f - l) / (1.f + expf(-res)); }
            else IM[r * EW + np - EW] = res; } }
    __syncthreads();
}
__device__ __forceinline__ void meta_e(Frame& F) {
    const float* FM = (const float*)(F.ws + WS_FM); const float* IM = (const float*)(F.ws + WS_IM); float* SM = (float*)(F.ws + WS_SMETA);
    for (int e = F.vcu * (NWAVES * 64) + F.tid; e < NHEAD * HD * HD; e += F.G * NWAVES * 64) { const int h = e >> 14, k = (e >> 7) & 127, v = e & 127; float S = 0.f;
        for (int s = 0; s < NMETA; ++s) { const float f = FM[s * EW + h * HD + k]; S = f * S + (1.f - f) * IM[s * EW + h * HD + v]; }
        SM[e] = S; }
}

__device__ __forceinline__ void p0_prologue(Frame& F) {
    LAS float* scr = (LAS float*)(F.lds + RING_OFF + F.wave * 16384);
    const int gw = F.vcu * NWAVES + F.wave, NGW = F.G * NWAVES;
    bf16_t* W1T = (bf16_t*)(F.ws + WS_W1T); bf16_t* WGT = (bf16_t*)(F.ws + WS_WGT); bf16_t* WINV = (bf16_t*)(F.ws + WS_WINV); bf16_t* WO0T = (bf16_t*)(F.ws + WS_WO0T);
    bf16_t* HWIN = (bf16_t*)(F.ws + WS_HWIN); bf16_t* HWOUT = (bf16_t*)(F.ws + WS_HWOUT); bf16_t* XN0 = (bf16_t*)(F.ws + WS_XN0);
    constexpr int I_GATE = (DM / 64) * (EW / 32), I_WG1 = (512 / 64) * (512 / 32), I_WG = 4 * I_WG1, I_WO0 = (EW / 64) * (DM / 32), I_HWIN = (DM / 64) * (8192 / 32), I_HWOUT = I_WO0;
    constexpr int NITEMS = I_GATE + I_WG + I_WO0 + I_HWIN + I_HWOUT;
    for (int it = gw; it < NITEMS; it += NGW) {
        int r = it;
        if (r < I_GATE) { p0_transpose_item(F.pwin, 4096, EW, DM, EW, W1T, EW, nullptr, scr, r, F.lane); continue; } r -= I_GATE;
        if (r < I_WG) { const int g = r / I_WG1; p0_transpose_item(F.pwgrp + (size_t)g * 512 * 512, 512, 0, 512, 512, WGT + (size_t)g * 512 * 512, 0, nullptr, scr, r % I_WG1, F.lane); continue; } r -= I_WG;
        if (r < I_WO0) { p0_transpose_item(F.pwout, DM, 0, EW, DM, WO0T, 0, nullptr, scr, r, F.lane); continue; } r -= I_WO0;
        if (r < I_HWIN) { p0_transpose_item(F.hwin, 8192, 0, DM, 8192, HWIN, 0, F.normw + DM, scr, r, F.lane); continue; } r -= I_HWIN;
        p0_transpose_item(F.hwout, DM, 0, EW, DM, HWOUT, 0, nullptr, scr, r, F.lane);
    }
    for (int idx = F.vcu * (NWAVES * 64) + F.tid; idx < DM * EW / 8; idx += F.G * NWAVES * 64) { const int k = idx >> 8, c8 = idx & 255;
        const f32x4 a = *(const f32x4*)(F.pwin + (size_t)k * 4096 + c8 * 8), b = *(const f32x4*)(F.pwin + (size_t)k * 4096 + c8 * 8 + 4);
        u32x4 o; o.x = pk2(a.x, a.y); o.y = pk2(a.z, a.w); o.z = pk2(b.x, b.y); o.w = pk2(b.z, b.w);
        *(u32x4*)(WINV + (size_t)k * EW + c8 * 8) = o; }
    { float* LB = (float*)(F.ws + WS_LB);
      for (int c = F.vcu * (NWAVES * 64) + F.tid; c < EW; c += F.G * NWAVES * 64) LB[c] = 1.f / (1.f + expf(F.hlb[c] - F.hlb[EW + c])); }
    for (int m = gw; m < MROWS; m += NGW) rms_row_to_bf16(F.lane, F.x + (size_t)m * DM, F.normw, XN0 + (size_t)m * DM);
}

__device__ __forceinline__ float unpk(const u32x4& v, int e) { const unsigned w = v[e >> 1]; return (e & 1) ? bf_hi(w) : bf_lo(w); }
template <int W> __device__ __forceinline__ void pool_run(const bf16_t* Z, const bf16_t* Gt, bf16_t* A2, const bf16_t* ZMB, const float* scale, int row0, int c0) {
    const int s0 = row0 & (SEQ - 1);
    u32x4 ring[W]; float S[8], sc[8];
#pragma unroll
    for (int e = 0; e < 8; ++e) { S[e] = 0.f; sc[e] = scale[c0 + e]; }
    const bf16_t* hsrc = (s0 != 0 ? Z + (size_t)(row0 - W) * EW : ZMB + (size_t)(NMETA - W) * EW) + c0;
#pragma unroll
    for (int j = 0; j < W; ++j) { const u32x4 p = *(const u32x4*)(hsrc + (size_t)j * EW);
        ring[j] = p;
#pragma unroll
        for (int e = 0; e < 8; ++e) S[e] += unpk(p, e); }
    constexpr float invW = 1.0f / (float)W;
#pragma unroll (W >= 8 ? 1 : 8 / W)
    for (int r0 = 0; r0 < 64; r0 += W) {
#pragma unroll
        for (int j = 0; j < W; ++j) { const size_t off = (size_t)(row0 + r0 + j) * EW + c0;
            const u32x4 x = *(const u32x4*)(Z + off), gt = *(const u32x4*)(Gt + off); float o[8];
#pragma unroll
            for (int e = 0; e < 8; ++e) { const float xe = unpk(x, e); S[e] += xe - unpk(ring[j], e); o[e] = (S[e] * invW - xe) * sc[e] * fast_silu(unpk(gt, e)); }
            ring[j] = x;
            u32x4 w; w.x = pk2(o[0], o[1]); w.y = pk2(o[2], o[3]); w.z = pk2(o[4], o[5]); w.w = pk2(o[6], o[7]);
            *(u32x4*)(A2 + off) = w; }
    }
}
__device__ __forceinline__ void pool_phase(Frame& F) {
    const bf16_t* Z = (const bf16_t*)(F.ws + WS_Z); const bf16_t* Gt = (const bf16_t*)(F.ws + WS_GATE); bf16_t* A2 = (bf16_t*)(F.ws + WS_A2); const bf16_t* ZM = (const bf16_t*)(F.ws + WS_ZMB);
    for (int item = F.vcu * (NWAVES * 64) + F.tid; item < (MROWS / 64) * (EW / 8); item += F.G * NWAVES * 64) {
        const int cg = item & 255, rr = item >> 8, grp = __builtin_amdgcn_readfirstlane(cg >> 6), c0 = cg * 8, row0 = rr * 64;
        if (grp == 0) pool_run<2>(Z, Gt, A2, ZM, F.pscale, row0, c0);
        else if (grp == 1) pool_run<4>(Z, Gt, A2, ZM, F.pscale, row0, c0);
        else if (grp == 2) pool_run<8>(Z, Gt, A2, ZM, F.pscale, row0, c0);
        else pool_run<16>(Z, Gt, A2, ZM, F.pscale, row0, c0);
    }
}

__device__ __forceinline__ void hgrn_baseline(Frame& F) {
    bf16_t* Q = (bf16_t*)(F.ws + WS_Z); const bf16_t* Gl = (const bf16_t*)(F.ws + WS_GATE); const bf16_t* V = (const bf16_t*)(F.ws + WS_A2);
    float* ssqh = (float*)(F.ws + WS_SSQH); const float* SM = (const float*)(F.ws + WS_SMETA);
    LAS f32x4* fkq = (LAS f32x4*)(F.lds); LAS float* vs = (LAS float*)(F.lds + 32768); LAS float* red = (LAS float*)(F.lds + 40960);
    const int kq = F.wave, vp = F.lane, lt = F.tid >> 5, lc = (F.tid & 31) * 4;
    for (int item = F.vcu; item < BATCH * NHEAD; item += F.G) { const int b = item >> 4, h = item & 15;
        float S0[16], S1[16];
#pragma unroll
        for (int j = 0; j < 16; ++j) { const f32x2 s2 = *(const f32x2*)(SM + ((size_t)(h * HD + kq * 16 + j)) * HD + 2 * vp); S0[j] = s2.x; S1[j] = s2.y; }
        for (int blk = 0; blk < SEQ / 16; ++blk) {
            const size_t rowb = (size_t)b * SEQ + (size_t)blk * 16;
            const size_t goff = (rowb + lt) * EW + h * HD + lc;
            const u32x2 qv = *(const u32x2*)(Q + goff), gv = *(const u32x2*)(Gl + goff), vv = *(const u32x2*)(V + goff);
            __syncthreads();
#pragma unroll
            for (int e = 0; e < 4; ++e) { const unsigned qw = qv[e >> 1], gw = gv[e >> 1], vw = vv[e >> 1];
                const float q = (e & 1) ? bf_hi(qw) : bf_lo(qw), g = (e & 1) ? bf_hi(gw) : bf_lo(gw), v = (e & 1) ? bf_hi(vw) : bf_lo(vw);
                const float f = fast_exp(g);
                fkq[lt * HD + lc + e] = (f32x4){f, 1.0f - f, q, 0.f}; vs[lt * HD + lc + e] = v; }
            __syncthreads();
#pragma unroll 2
            for (int t = 0; t < 16; ++t) { const f32x2 v2 = *(const LAS f32x2*)(vs + t * HD + 2 * vp); float o0 = 0.f, o1 = 0.f;
#pragma unroll
                for (int j = 0; j < 16; ++j) { const f32x4 c = fkq[t * HD + kq * 16 + j];
                    S0[j] = c.x * S0[j] + c.y * v2.x; S1[j] = c.x * S1[j] + c.y * v2.y; o0 += c.z * S0[j]; o1 += c.z * S1[j]; }
                *(LAS f32x2*)(red + (kq * 16 + t) * HD + 2 * vp) = (f32x2){o0, o1}; }
            __syncthreads();
            f32x4 o = (f32x4){0.f, 0.f, 0.f, 0.f};
#pragma unroll
            for (int w = 0; w < 8; ++w) o += *(const LAS f32x4*)(red + (w * 16 + lt) * HD + lc);
            float ss = (o.x * o.x + o.y * o.y) + (o.z * o.z + o.w * o.w);
#pragma unroll
            for (int m = 1; m < 32; m <<= 1) ss += __shfl_xor(ss, m);
            if ((F.tid & 31) == 0) ssqh[(rowb + lt) * NHEAD + h] = ss;
            u32x2 ow; ow.x = pk2(o.x, o.y); ow.y = pk2(o.z, o.w);
            *(u32x2*)(Q + goff) = ow;
        }
        __syncthreads();
    }
}

__device__ __forceinline__ void final_norm(Frame& F) {
    const int gw = F.vcu * NWAVES + F.wave, NGW = F.G * NWAVES;
    for (int m = gw; m < MROWS; m += NGW) {
        GAS f32x4* xr = (GAS f32x4*)(F.out + (size_t)m * DM) + F.lane; const GAS f32x4* wr = (const GAS f32x4*)F.fnw + F.lane;
        f32x4 v[4]; float s = 0.f;
#pragma unroll
        for (int j = 0; j < 4; ++j) { v[j] = xr[64 * j]; s += (v[j].x * v[j].x + v[j].y * v[j].y) + (v[j].z * v[j].z + v[j].w * v[j].w); }
        const float rstd = 1.f / sqrtf(wave_sum(s) * (1.f / DM) + EPS);
#pragma unroll
        for (int j = 0; j < 4; ++j) { const f32x4 ww = wr[64 * j]; xr[64 * j] = (f32x4){v[j].x * rstd * ww.x, v[j].y * rstd * ww.y, v[j].z * rstd * ww.z, v[j].w * rstd * ww.w}; }
    }
}

struct Args { const float* in[12]; float* out; unsigned char* ws; int ph_lo, ph_hi; };
__global__ void __launch_bounds__(NWAVES * 64, 2) trunk_fwd(Args args) {
    extern __shared__ __attribute__((aligned(16))) unsigned char lds[];
    Frame F;
    F.lds = (LAS unsigned char*)lds;
    F.MISC = (volatile LAS unsigned*)(F.lds + MISC_OFF);
    F.tid = threadIdx.x; F.lane = F.tid & 63; F.wave = __builtin_amdgcn_readfirstlane(F.tid >> 6);
    F.G = gridDim.x; { const int bx = blockIdx.x; F.vcu = (F.G % 8 == 0) ? (bx % 8) * (F.G / 8) + bx / 8 : bx; }
    F.ws = args.ws; F.ctl = (gu32*)(args.ws + WS_CTL);
    F.x = args.in[0]; F.meta = args.in[1]; F.normw = args.in[2]; F.pwin = args.in[3]; F.pwgrp = args.in[4]; F.pscale = args.in[5]; F.pwout = args.in[6];
    F.hwin = args.in[7]; F.hlb = args.in[8]; F.honorm = args.in[9]; F.hwout = args.in[10]; F.fnw = args.in[11]; F.out = args.out;
    for (int u = F.tid; u < (LDS_BYTES - LDSCTL_OFF) / 4; u += NWAVES * 64) ((LAS unsigned*)(F.lds + LDSCTL_OFF))[u] = 0u;
    __syncthreads();
    XcdBarrier bar; bar.bar = (unsigned*)(F.ctl + CW_BAR); bar.x = 0; bar.st = nullptr;
    if (MK_N_LAUNCHES == 1) bar = xcd_barrier_post((unsigned*)(F.ctl + CW_BAR), F.MISC + 8);
    const int lo = args.ph_lo, hi = args.ph_hi;
#define IN(k) (lo <= (k) && (k) < hi)
#define SEAM(k) do { if (IN(k) && IN((k) + 1)) xcd_barrier(bar); } while (0)
    bf16_t* const W1T = (bf16_t*)(F.ws + WS_W1T); bf16_t* const WGT = (bf16_t*)(F.ws + WS_WGT); bf16_t* const WINV = (bf16_t*)(F.ws + WS_WINV); bf16_t* const WO0T = (bf16_t*)(F.ws + WS_WO0T);
    bf16_t* const HWIN = (bf16_t*)(F.ws + WS_HWIN); bf16_t* const HWOUT = (bf16_t*)(F.ws + WS_HWOUT);
    bf16_t* const XN0 = (bf16_t*)(F.ws + WS_XN0); bf16_t* const H1B = XN0; bf16_t* const ZB = (bf16_t*)(F.ws + WS_Z); bf16_t* const GB = (bf16_t*)(F.ws + WS_GATE); bf16_t* const A2B = (bf16_t*)(F.ws + WS_A2);
    float* const SSQ1 = (float*)(F.ws + WS_SSQ1); float* const SSQH = (float*)(F.ws + WS_SSQH); const float* const LB = (const float*)(F.ws + WS_LB);

    if (IN(0)) { meta_a(F); p0_prologue(F); }
    SEAM(0);
    if (IN(1)) {
        meta_b(F);
        pg8::Gemm g{WGT, WINV}; pg8::GroupOrder S{2, 4, 4, F.G, (int)blockIdx.x};
        pg8::EpiBf16Plain E{W1T, DM, (size_t)512 * DM, 0, 0};
        pg8::gemm_phase<pg8::EpiBf16Plain, pg8::GroupOrder, false, true, 512, 512, EW, 512 * 512, 512>(F.lds + RING_OFF, g, S, E);
    }
    SEAM(1);
    if (IN(2)) {
        meta_c(F);
        pg8::Gemm g{XN0, W1T}; pg8::StaticOrder S; S.init(MROWS, 4096, F.G, (int)blockIdx.x);
        pg8::EpiBf16Plain E{ZB, EW, 0, EW, (size_t)(WS_GATE - WS_Z) / 2};
        pg8::gemm_phase<pg8::EpiBf16Plain, pg8::StaticOrder, true, true, DM, DM, DM>(F.lds + RING_OFF, g, S, E);
    }
    SEAM(2);
    if (IN(3)) { meta_d(F); pool_phase(F); }
    SEAM(3);
    if (IN(4)) {
        meta_e(F);
        pg8::Gemm g{A2B, WO0T}; pg8::StaticOrder S; S.init(MROWS, DM, F.G, (int)blockIdx.x);
        pg8::EpiResid E{F.x, F.out, H1B, SSQ1};
        pg8::gemm_phase<pg8::EpiResid, pg8::StaticOrder, true, true, EW, EW, EW>(F.lds + RING_OFF, g, S, E);
    }
    SEAM(4);
    if (IN(5)) {
        pg8::Gemm g{H1B, HWIN}; pg8::StaticOrder S; S.init(MROWS, 6144, F.G, (int)blockIdx.x);
        static_assert(WS_GATE - WS_Z == WS_A2 - WS_GATE, "Q, G, V equally spaced"); pg8::EpiHgrn E{SSQ1, LB, ZB, (size_t)(WS_GATE - WS_Z) / 2};
        pg8::gemm_phase<pg8::EpiHgrn, pg8::StaticOrder, true, true, DM, DM, DM>(F.lds + RING_OFF, g, S, E);
    }
    SEAM(5);
    if (IN(6)) hgrn_baseline(F);
    SEAM(6);
    if (IN(7)) {
        pg8::Gemm g{H1B, HWIN + (size_t)6144 * DM}; pg8::StaticOrder S; S.init(MROWS, EW, F.G, (int)blockIdx.x);
        pg8::EpiGate E{SSQ1, SSQH, F.honorm, ZB};
        pg8::gemm_phase<pg8::EpiGate, pg8::StaticOrder, true, true, DM, DM, DM>(F.lds + RING_OFF, g, S, E);
    }
    SEAM(7);
    if (IN(8)) {
        pg8::Gemm g{ZB, HWOUT}; pg8::StaticOrder S; S.init(MROWS, DM, F.G, (int)blockIdx.x);
        pg8::EpiResid E{F.out, F.out, nullptr, nullptr};
        pg8::gemm_phase<pg8::EpiResid, pg8::StaticOrder, true, true, EW, EW, EW>(F.lds + RING_OFF, g, S, E);
    }
    SEAM(8);
    if (IN(9)) final_norm(F);
#undef IN
#undef SEAM
}

extern "C" void kernel_launch(void* const* d_in, const int* in_sizes, int n_in, void* d_out, int out_size, void* d_ws, size_t ws_size, hipStream_t stream) {
    static int grid = 0;
    if (grid == 0) {
        if (n_in != 12 || in_sizes[0] != MROWS * DM || out_size != MROWS * DM || ws_size < WS_END) { fprintf(stderr, "kernel_launch: unexpected shapes (n_in %d, in0 %d, out %d, ws %zu); nothing launched\n", n_in, n_in > 0 ? in_sizes[0] : -1, out_size, ws_size); grid = -1; return; }
        int dev = 0, cus = 0, per_cu = 0;
        if (hipGetDevice(&dev) != hipSuccess || hipDeviceGetAttribute(&cus, hipDeviceAttributeMultiprocessorCount, dev) != hipSuccess) { fprintf(stderr, "kernel_launch: device query failed\n"); grid = -1; return; }
        if (hipFuncSetAttribute((const void*)trunk_fwd, hipFuncAttributeMaxDynamicSharedMemorySize, LDS_BYTES) != hipSuccess) { fprintf(stderr, "kernel_launch: hipFuncSetAttribute failed\n"); grid = -1; return; }
        if (hipOccupancyMaxActiveBlocksPerMultiprocessor(&per_cu, (const void*)trunk_fwd, NWAVES * 64, LDS_BYTES) != hipSuccess || per_cu < 1)
            fprintf(stderr, "kernel_launch: note: occupancy query reports %d workgroups per CU\n", per_cu);
        (void)hipGetLastError();
        grid = cus;
    }
    if (grid < 0) return;
    if (hipMemsetAsync((char*)d_ws + WS_CTL, 0, CTL_ZERO_BYTES, stream) != hipSuccess) { fprintf(stderr, "kernel_launch: hipMemsetAsync failed\n"); return; }
    Args a{};
    for (int i = 0; i < 12; ++i) a.in[i] = (const float*)d_in[i];
    a.out = (float*)d_out; a.ws = (unsigned char*)d_ws;
#if MK_N_LAUNCHES == 1
    a.ph_lo = 0; a.ph_hi = N_PHASES;
    hipLaunchKernelGGL(trunk_fwd, dim3(grid), dim3(NWAVES * 64), LDS_BYTES, stream, a);
#else
    for (int p = 0; p < N_PHASES; ++p) { a.ph_lo = p; a.ph_hi = p + 1; hipLaunchKernelGGL(trunk_fwd, dim3(grid), dim3(NWAVES * 64), LDS_BYTES, stream, a); }
#endif
    const hipError_t le = hipPeekAtLastError();
    if (le != hipSuccess) fprintf(stderr, "kernel_launch: launch failed: %s\n", hipGetErrorName(le));
}
```

```cpp
#include <hip/hip_runtime.h>
#include <cstdio>
#include <cstdint>

#define LAS __attribute__((address_space(3)))
#define GAS __attribute__((address_space(1)))
typedef unsigned short bf16_t;
typedef short bf16x8 __attribute__((ext_vector_type(8)));
typedef float f32x4 __attribute__((ext_vector_type(4)));
typedef float f32x2 __attribute__((ext_vector_type(2)));
typedef unsigned u32x4 __attribute__((ext_vector_type(4)));
typedef unsigned u32x2 __attribute__((ext_vector_type(2)));

constexpr int BATCH = 4, SEQ = 8192, DM = 1024, MROWS = BATCH * SEQ, EW = 2048, NMETA = 16, NHEAD = 16, HD = 128;
constexpr float EPS = 1e-6f;
constexpr int NWAVES = 8;

__device__ __forceinline__ unsigned f2bf(float f) { unsigned u = __builtin_bit_cast(unsigned, f); return (u + 0x7fffu + ((u >> 16) & 1u)) >> 16; }
__device__ __forceinline__ unsigned pk2(float lo, float hi) { return f2bf(lo) | (f2bf(hi) << 16); }
__device__ __forceinline__ float bf_lo(unsigned w) { return __builtin_bit_cast(float, w << 16); }
__device__ __forceinline__ float bf_hi(unsigned w) { return __builtin_bit_cast(float, w & 0xffff0000u); }
__device__ __forceinline__ float fast_sigmoid(float x) { return __builtin_amdgcn_rcpf(1.0f + __builtin_amdgcn_exp2f(-1.44269504089f * x)); }
__device__ __forceinline__ float fast_silu(float x) { return x * fast_sigmoid(x); }
__device__ __forceinline__ float fast_exp(float x) { return __builtin_amdgcn_exp2f(1.44269504089f * x); }

namespace pg8 {
#define PG8_LAS __attribute__((address_space(3)))
constexpr int BM = 256, BK = 64, HALF = 128, HTB = HALF * BK * 2  , STAGE_BYTES = 8 * HTB, NXCD = 8, WGM = 8;

__host__ __device__ __forceinline__ int lds_byte(int r, int c) { const int st = (r >> 4) * 2 + (c >> 5), rr = r & 15, cc = c & 31, ob = rr * 64 + cc * 2; return st * 1024 + (ob ^ (((ob >> 9) & 1) << 5)); }
__host__ __device__ __forceinline__ void stage_rc(int b, int& R, int& C) { const int st = b / 1024, sb = b % 1024, swz = sb ^ (((sb >> 9) & 1) << 5); R = (st >> 1) * 16 + swz / 64; C = (st & 1) * 32 + (swz % 64) / 2; }
__host__ __device__ __forceinline__ int perm32(int rho) { const int n = rho >> 4, i = rho & 15; return 8 * (i >> 2) + 4 * n + (i & 3); }

struct Unit { int pm, pn, g; };
struct Gemm { const bf16_t* A; const bf16_t* Bt; };

struct StaticOrder {
    int nM, nN, nwg, G, c;
    __host__ __device__ void init(int M, int N, int G_, int c_) { nM = M / BM; nN = N / BM; nwg = nM * nN; G = G_; c = c_; }
    __host__ __device__ bool next(int i, Unit& u) const {
        const long L = (long)i * G + c; if (L >= nwg) return false;
        int wgid = (int)L; { const int q = nwg / NXCD, r = nwg % NXCD, xcd = wgid % NXCD, off = wgid / NXCD; wgid = (xcd < r ? xcd * (q + 1) : r * (q + 1) + (xcd - r) * q) + off; }
        const int nig = WGM * nN, gid = wgid / nig, fm = gid * WGM, gsz = (nM - fm) < WGM ? (nM - fm) : WGM;
        u.pm = fm + ((wgid % nig) % gsz); u.pn = (wgid % nig) / gsz; u.g = 0; return true;
    }
    __device__ __forceinline__ void a_ready(const Unit&) const {}
    __device__ __forceinline__ void done(const Unit&) const {}
};
struct GroupOrder {
    int nM, nN, ngrp, G, c;
    __host__ __device__ bool next(int i, Unit& u) const {
        const long L = (long)i * G + c; if (L >= (long)nM * nN * ngrp) return false;
        const int per = nM * nN; u.g = (int)L / per; const int r = (int)L % per; u.pm = r / nN; u.pn = r % nN; return true;
    }
    __device__ __forceinline__ void a_ready(const Unit&) const {}
    __device__ __forceinline__ void done(const Unit&) const {}
};

__device__ __forceinline__ unsigned cvt_pk_bf16(float lo, float hi) { unsigned r; asm volatile("v_cvt_pk_bf16_f32 %0, %1, %2" : "=v"(r) : "v"(lo), "v"(hi)); return r; }

template <class Epi, class Sched, bool ALIGN_EPI, bool SP2, int KK, int LDA, int LDB, int GA = 0, int GB = 0>
__device__ __forceinline__ void gemm_phase(PG8_LAS unsigned char* lds, const Gemm g, const Sched& S, const Epi& E) {
    const int tid = threadIdx.x, wid = __builtin_amdgcn_readfirstlane(tid >> 6), lane = tid & 63, wr = wid >> 2, wc = wid & 3, fr = lane & 15, fq = lane >> 4;
    constexpr int K = KK, nt = K / BK;
    unsigned voffA[2], voffB[2];
#pragma unroll
    for (int i = 0; i < 2; ++i) { int R, C; stage_rc(tid * 16 + i * 8192, R, C); const int Rb = Epi::PERM ? ((R & ~31) + perm32(R & 31)) : R;
        voffA[i] = (unsigned)(R * LDA + C) * 2u; voffB[i] = (unsigned)(Rb * LDB + C) * 2u; }
    const size_t kstep = (size_t)(BK * 2);
    const size_t hstepA = (size_t)HALF * LDA * 2, hstepB = (size_t)HALF * LDB * 2;
    const size_t tstepA = 2 * hstepA, tstepB = 2 * hstepB;
    const unsigned ldsw = (unsigned)wid * 1024u;
    const int aoff = lds_byte(wr * 64 + fr, fq * 8), boff = lds_byte(wc * 32 + fr, fq * 8);
#define PG8_SA(b, h) (((b) * 2 + (h)) * HTB)
#define PG8_SB(b, h) ((4 + (b) * 2 + (h)) * HTB)
#define PG8_STAGE(bufoff, gbase, voff) do { _Pragma("unroll") for (int _i = 0; _i < 2; ++_i) \
        __builtin_amdgcn_global_load_lds((const unsigned*)((const char*)(gbase) + (voff)[_i]), (PG8_LAS unsigned*)(lds + (bufoff) + ldsw + _i * 8192), 16, 0, 0); } while (0)
#define PG8_LDA(dst, b, h) do { _Pragma("unroll") for (int m = 0; m < 4; ++m) _Pragma("unroll") for (int k = 0; k < 2; ++k) dst[m][k] = *(const PG8_LAS bf16x8*)(lds + PG8_SA(b, h) + aoff + m * 2048 + k * 1024); } while (0)
#define PG8_LDB(dst, b, h) do { _Pragma("unroll") for (int n = 0; n < 2; ++n) _Pragma("unroll") for (int k = 0; k < 2; ++k) dst[n][k] = *(const PG8_LAS bf16x8*)(lds + PG8_SB(b, h) + boff + n * 2048 + k * 1024); } while (0)
#define PG8_MMA(ai, bj, At, Bt) do { __builtin_amdgcn_s_setprio(1); _Pragma("unroll") for (int m = 0; m < 4; ++m) _Pragma("unroll") for (int n = 0; n < 2; ++n) _Pragma("unroll") for (int k = 0; k < 2; ++k) \
        acc[ai][bj][m][n] = __builtin_amdgcn_mfma_f32_16x16x32_bf16(Bt[n][k], At[m][k], acc[ai][bj][m][n], 0, 0, 0); __builtin_amdgcn_s_setprio(0); } while (0)
#define PG8_WAIT_V(n) asm volatile("s_waitcnt vmcnt(" #n ")" ::: "memory")
#define PG8_WAIT_L(n) asm volatile("s_waitcnt lgkmcnt(" #n ")" ::: "memory")
#define PG8_BAR __builtin_amdgcn_s_barrier()
#define PG8_SCHED __builtin_amdgcn_sched_barrier(0)
    Unit cur, nxt; int ui = 0;
    if (!S.next(0, cur)) return;
    f32x4 acc[2][2][4][2];
#pragma unroll
    for (int a = 0; a < 2; ++a)
#pragma unroll
        for (int b = 0; b < 2; ++b)
#pragma unroll
            for (int m = 0; m < 4; ++m)
#pragma unroll
                for (int n = 0; n < 2; ++n) acc[a][b][m][n] = (f32x4){0.f, 0.f, 0.f, 0.f};
    bf16x8 At[4][2], B0[2][2], B1[2][2];
    const char* cA = (const char*)g.A + (size_t)cur.g * (size_t)GA * 2 + (size_t)cur.pm * tstepA; const char* cB = (const char*)g.Bt + (size_t)cur.g * (size_t)GB * 2 + (size_t)cur.pn * tstepB;
    S.a_ready(cur);
    if constexpr (SP2) {
        PG8_STAGE(PG8_SB(0, 0), cB, voffB); PG8_STAGE(PG8_SB(0, 1), cB + hstepB, voffB); PG8_STAGE(PG8_SA(0, 0), cA, voffA); PG8_STAGE(PG8_SA(0, 1), cA + hstepA, voffA);
        if (wr == 1) PG8_BAR;
        PG8_WAIT_V(2); PG8_BAR;
        PG8_STAGE(PG8_SB(1, 0), cB + kstep, voffB); PG8_STAGE(PG8_SA(1, 0), cA + kstep, voffA); PG8_STAGE(PG8_SB(1, 1), cB + hstepB + kstep, voffB);
        PG8_WAIT_V(6); PG8_BAR;
    } else {
        PG8_STAGE(PG8_SB(0, 0), cB, voffB); PG8_STAGE(PG8_SA(0, 0), cA, voffA); PG8_STAGE(PG8_SB(0, 1), cB + hstepB, voffB); PG8_STAGE(PG8_SA(0, 1), cA + hstepA, voffA);
        if (wr == 1) PG8_BAR;
        PG8_WAIT_V(4); PG8_BAR;
        PG8_STAGE(PG8_SB(1, 0), cB + kstep, voffB); PG8_STAGE(PG8_SA(1, 0), cA + kstep, voffA); PG8_STAGE(PG8_SB(1, 1), cB + hstepB + kstep, voffB);
        PG8_WAIT_V(6); PG8_BAR;
    }
    for (;;) {
        const bool has_next = S.next(ui + 1, nxt);
        const char* nA = has_next ? (const char*)g.A + (size_t)nxt.g * (size_t)GA * 2 + (size_t)nxt.pm * tstepA : cA; const char* nB = has_next ? (const char*)g.Bt + (size_t)nxt.g * (size_t)GB * 2 + (size_t)nxt.pn * tstepB : cB;
        for (int t = 0; t < nt; t += 2) {
            const bool last = (t == nt - 2);
            const char* a1 = cA + (size_t)(t + 1) * kstep;
            const char* a2 = last ? nA : cA + (size_t)(t + 2) * kstep; const char* b2 = last ? nB : cB + (size_t)(t + 2) * kstep;
            const char* a3 = a2 + kstep; const char* b3 = b2 + kstep;
            if (last && has_next) S.a_ready(nxt);
            if constexpr (SP2) {
            PG8_LDB(B0, 0, 0); PG8_LDB(B1, 0, 1); PG8_SCHED; PG8_LDA(At, 0, 0); PG8_STAGE(PG8_SA(1, 1), a1 + hstepA, voffA);
            PG8_WAIT_V(8); PG8_WAIT_L(0); PG8_BAR; PG8_MMA(0, 0, At, B0); PG8_MMA(0, 1, At, B1); PG8_BAR; PG8_SCHED;
            PG8_LDA(At, 0, 1); PG8_STAGE(PG8_SB(0, 0), b2, voffB); PG8_STAGE(PG8_SB(0, 1), b2 + hstepB, voffB); PG8_STAGE(PG8_SA(0, 0), a2, voffA);
            PG8_WAIT_V(8); PG8_WAIT_L(0); PG8_BAR; PG8_MMA(1, 0, At, B0); PG8_MMA(1, 1, At, B1); PG8_BAR; PG8_SCHED;
            PG8_LDB(B0, 1, 0); PG8_LDB(B1, 1, 1); PG8_SCHED; PG8_LDA(At, 1, 0); PG8_STAGE(PG8_SA(0, 1), a2 + hstepA, voffA);
            PG8_WAIT_V(8); PG8_WAIT_L(0); PG8_BAR; PG8_MMA(0, 0, At, B0); PG8_MMA(0, 1, At, B1); PG8_BAR; PG8_SCHED;
            PG8_LDA(At, 1, 1); PG8_STAGE(PG8_SB(1, 0), b3, voffB); PG8_STAGE(PG8_SB(1, 1), b3 + hstepB, voffB); PG8_STAGE(PG8_SA(1, 0), a3, voffA);
            PG8_WAIT_V(8); PG8_WAIT_L(0); PG8_BAR; PG8_MMA(1, 0, At, B0); PG8_MMA(1, 1, At, B1); PG8_BAR; PG8_SCHED;
            } else {
            PG8_LDB(B0, 0, 0); PG8_SCHED; PG8_LDA(At, 0, 0); PG8_STAGE(PG8_SA(1, 1), a1 + hstepA, voffA);
            PG8_WAIT_L(8); PG8_BAR; PG8_WAIT_L(0); PG8_MMA(0, 0, At, B0); PG8_BAR; PG8_SCHED;
            PG8_LDB(B1, 0, 1); PG8_STAGE(PG8_SB(0, 0), b2, voffB);
            PG8_BAR; PG8_WAIT_L(0); PG8_MMA(0, 1, At, B1); PG8_BAR;
            PG8_LDA(At, 0, 1); PG8_STAGE(PG8_SA(0, 0), a2, voffA);
            PG8_BAR; PG8_WAIT_L(0); PG8_MMA(1, 0, At, B0); PG8_BAR; PG8_SCHED;
            PG8_STAGE(PG8_SB(0, 1), b2 + hstepB, voffB);
            PG8_WAIT_V(6); PG8_BAR; PG8_MMA(1, 1, At, B1); PG8_BAR;
            PG8_LDB(B0, 1, 0); PG8_SCHED; PG8_LDA(At, 1, 0); PG8_STAGE(PG8_SA(0, 1), a2 + hstepA, voffA);
            PG8_WAIT_L(8); PG8_BAR; PG8_WAIT_L(0); PG8_MMA(0, 0, At, B0); PG8_BAR; PG8_SCHED;
            PG8_LDB(B1, 1, 1); PG8_STAGE(PG8_SB(1, 0), b3, voffB);
            PG8_BAR; PG8_WAIT_L(0); PG8_MMA(0, 1, At, B1); PG8_BAR;
            PG8_LDA(At, 1, 1); PG8_STAGE(PG8_SA(1, 0), a3, voffA);
            PG8_BAR; PG8_WAIT_L(0); PG8_MMA(1, 0, At, B0); PG8_BAR; PG8_SCHED;
            PG8_STAGE(PG8_SB(1, 1), b3 + hstepB, voffB);
            PG8_WAIT_V(6); PG8_BAR; PG8_MMA(1, 1, At, B1); PG8_BAR;
            }
        }
        if constexpr (ALIGN_EPI) { if (wr == 0) PG8_BAR; }
        if constexpr (!Epi::AFTER_DRAIN) { E(acc, cur, wr, wc, fr, fq); S.done(cur); }
        if (!has_next) break;
#pragma unroll
        for (int a = 0; a < 2; ++a)
#pragma unroll
            for (int b = 0; b < 2; ++b)
#pragma unroll
                for (int m = 0; m < 4; ++m)
#pragma unroll
                    for (int n = 0; n < 2; ++n) acc[a][b][m][n] = (f32x4){0.f, 0.f, 0.f, 0.f};
        cur = nxt; cA = nA; cB = nB; ++ui;
        if constexpr (ALIGN_EPI) { if (wr == 1) PG8_BAR; }
    }
    PG8_WAIT_V(0);
    if constexpr (!ALIGN_EPI) { if (wr == 0) PG8_BAR; }
    PG8_BAR;
    if constexpr (Epi::AFTER_DRAIN) { E.fused(acc, cur, wr, wc, fr, fq, lds, wid, lane); S.done(cur); }
#undef PG8_SA
#undef PG8_SB
#undef PG8_STAGE
#undef PG8_LDA
#undef PG8_LDB
#undef PG8_MMA
#undef PG8_WAIT_V
#undef PG8_WAIT_L
#undef PG8_BAR
#undef PG8_SCHED
}

struct EpiBf16Plain {
    static constexpr bool PERM = true, AFTER_DRAIN = false;
    bf16_t* O; int ldc; size_t gO; int split_cols; size_t split_stride;
    __device__ __forceinline__ void operator()(const f32x4 (&acc)[2][2][4][2], const Unit& u, int wr, int wc, int fr, int fq) const {
        const int row0 = u.pm * BM + wr * 64 + fr; int colt = u.pn * BM; bf16_t* base = O + (size_t)u.g * gO;
        if (split_cols) { const int t = colt / split_cols; base += (size_t)t * split_stride; colt -= t * split_cols; }
        const int col0 = colt + wc * 32 + 8 * fq;
#pragma unroll
        for (int ai = 0; ai < 2; ++ai)
#pragma unroll
            for (int m = 0; m < 4; ++m) { bf16_t* rowp = base + (size_t)(row0 + ai * HALF + m * 16) * ldc + col0;
#pragma unroll
                for (int bj = 0; bj < 2; ++bj) { const f32x4 v0 = acc[ai][bj][m][0], v1 = acc[ai][bj][m][1];
                    u32x4 w; w.x = cvt_pk_bf16(v0[0], v0[1]); w.y = cvt_pk_bf16(v0[2], v0[3]); w.z = cvt_pk_bf16(v1[0], v1[1]); w.w = cvt_pk_bf16(v1[2], v1[3]);
                    *(u32x4*)(rowp + bj * HALF) = w; } }
    }
};
struct EpiResid {
    static constexpr bool PERM = true, AFTER_DRAIN = false;
    const float* base; float* out; bf16_t* ob; float* ssq;
    __device__ __forceinline__ void operator()(const f32x4 (&acc)[2][2][4][2], const Unit& u, int wr, int wc, int fr, int fq) const {
        const int row0 = u.pm * BM + wr * 64 + fr, col0 = u.pn * BM + wc * 32 + 8 * fq;
#pragma unroll
        for (int ai = 0; ai < 2; ++ai)
#pragma unroll
            for (int m = 0; m < 4; ++m) { const int r = row0 + ai * HALF + m * 16; const size_t off = (size_t)r * DM + col0; float s = 0.f;
#pragma unroll
                for (int bj = 0; bj < 2; ++bj) {
                    const f32x4 b0 = *(const f32x4*)(base + off + bj * HALF), b1 = *(const f32x4*)(base + off + bj * HALF + 4);
                    const f32x4 v0 = acc[ai][bj][m][0] + b0, v1 = acc[ai][bj][m][1] + b1;
                    *(f32x4*)(out + off + bj * HALF) = v0; *(f32x4*)(out + off + bj * HALF + 4) = v1;
                    if (ob) { u32x4 w; w.x = cvt_pk_bf16(v0[0], v0[1]); w.y = cvt_pk_bf16(v0[2], v0[3]); w.z = cvt_pk_bf16(v1[0], v1[1]); w.w = cvt_pk_bf16(v1[2], v1[3]); *(u32x4*)(ob + off + bj * HALF) = w; }
                    s += (v0[0] * v0[0] + v0[1] * v0[1]) + (v0[2] * v0[2] + v0[3] * v0[3]) + (v1[0] * v1[0] + v1[1] * v1[1]) + (v1[2] * v1[2] + v1[3] * v1[3]); }
                if (ssq) { s += __shfl_xor(s, 16); s += __shfl_xor(s, 32); if (fq == 0) atomicAdd(ssq + r, s); } }
    }
};
struct EpiHgrn {
    static constexpr bool PERM = true, AFTER_DRAIN = false;
    const float* ssq1; const float* lb; bf16_t* Q; size_t pstride;
    __device__ __forceinline__ void operator()(const f32x4 (&acc)[2][2][4][2], const Unit& u, int wr, int wc, int fr, int fq) const {
        const int part = u.pn >> 3, colt = (u.pn & 7) * BM;
        bf16_t* O = Q + (size_t)part * pstride;
        const int row0 = u.pm * BM + wr * 64 + fr, col0 = colt + wc * 32 + 8 * fq;
        f32x4 lbv[2][2];
#pragma unroll
        for (int bj = 0; bj < 2; ++bj)
#pragma unroll
            for (int n = 0; n < 2; ++n) lbv[bj][n] = *(const f32x4*)(lb + col0 + bj * HALF + 4 * n);
#pragma unroll
        for (int ai = 0; ai < 2; ++ai)
#pragma unroll
            for (int m = 0; m < 4; ++m) { const int r = row0 + ai * HALF + m * 16; const float rs = __builtin_amdgcn_rsqf(ssq1[r] * (1.0f / DM) + EPS);
                bf16_t* rowp = O + (size_t)r * EW + col0;
#pragma unroll
                for (int bj = 0; bj < 2; ++bj) { float x[8];
#pragma unroll
                    for (int e = 0; e < 8; ++e) { const float a = acc[ai][bj][m][e >> 2][e & 3] * rs;
                        if (part == 0) x[e] = fast_silu(a);
                        else if (part == 1) { const float l = lbv[bj][e >> 2][e & 3]; const float f = l + (1.0f - l) * fast_sigmoid(a); x[e] = 0.69314718056f * __builtin_amdgcn_logf(f); }
                        else x[e] = a; }
                    u32x4 w; w.x = cvt_pk_bf16(x[0], x[1]); w.y = cvt_pk_bf16(x[2], x[3]); w.z = cvt_pk_bf16(x[4], x[5]); w.w = cvt_pk_bf16(x[6], x[7]);
                    *(u32x4*)(rowp + bj * HALF) = w; } }
    }
};
struct EpiGate {
    static constexpr bool PERM = true, AFTER_DRAIN = false;
    const float* ssq1; const float* ssqh; const float* onorm; bf16_t* O;
    __device__ __forceinline__ void operator()(const f32x4 (&acc)[2][2][4][2], const Unit& u, int wr, int wc, int fr, int fq) const {
        const int row0 = u.pm * BM + wr * 64 + fr, col0 = u.pn * BM + wc * 32 + 8 * fq;
        f32x4 onv[2][2];
#pragma unroll
        for (int bj = 0; bj < 2; ++bj)
#pragma unroll
            for (int n = 0; n < 2; ++n) onv[bj][n] = *(const f32x4*)(onorm + col0 + bj * HALF + 4 * n);
#pragma unroll
        for (int ai = 0; ai < 2; ++ai)
#pragma unroll
            for (int m = 0; m < 4; ++m) { const int r = row0 + ai * HALF + m * 16; const float rs = __builtin_amdgcn_rsqf(ssq1[r] * (1.0f / DM) + EPS);
                bf16_t* rowp = O + (size_t)r * EW + col0;
#pragma unroll
                for (int bj = 0; bj < 2; ++bj) { const float rh = __builtin_amdgcn_rsqf(ssqh[(size_t)r * NHEAD + 2 * u.pn + bj] * (1.0f / HD) + EPS);
                    const u32x4 ov = *(const u32x4*)(rowp + bj * HALF); float x[8];
#pragma unroll
                    for (int e = 0; e < 8; ++e) { const unsigned wv = ov[e >> 1]; const float o = (e & 1) ? bf_hi(wv) : bf_lo(wv);
                        const float gt = fast_silu(acc[ai][bj][m][e >> 2][e & 3] * rs);
                        x[e] = o * rh * onv[bj][e >> 2][e & 3] * gt; }
                    u32x4 w; w.x = cvt_pk_bf16(x[0], x[1]); w.y = cvt_pk_bf16(x[2], x[3]); w.z = cvt_pk_bf16(x[4], x[5]); w.w = cvt_pk_bf16(x[6], x[7]);
                    *(u32x4*)(rowp + bj * HALF) = w; } }
    }
};
}

#ifndef MK_N_LAUNCHES
#define MK_N_LAUNCHES 1
#endif
constexpr int N_PHASES = 11;

constexpr size_t MiB = 1u << 20, KiB = 1u << 10;
constexpr size_t WS_CTL = 0, CTL_ZERO_BYTES = 1 * MiB;
constexpr size_t WS_SSQ1 = 256 * KiB;
constexpr size_t WS_W1T = 1 * MiB;
constexpr size_t WS_WGT = 9 * MiB;
constexpr size_t WS_WINV = 11 * MiB;
constexpr size_t WS_WO0T = 15 * MiB;
constexpr size_t WS_HWIN = 19 * MiB;
constexpr size_t WS_HWOUT = 35 * MiB;
constexpr size_t WS_SMALL = 39 * MiB;
constexpr size_t WS_LB = WS_SMALL;
constexpr size_t WS_VGM = WS_SMALL + 320 * KiB;
constexpr size_t WS_ZM = WS_SMALL + 576 * KiB;
constexpr size_t WS_ZMB = WS_SMALL + 1152 * KiB;
constexpr size_t WS_A2M = WS_SMALL + 704 * KiB;
constexpr size_t WS_H1M = WS_SMALL + 832 * KiB;
constexpr size_t WS_FM = WS_SMALL + 896 * KiB;
constexpr size_t WS_IM = WS_SMALL + 1024 * KiB;
constexpr size_t WS_SMETA = WS_SMALL + 2048 * KiB;
constexpr size_t WS_LSEG = 1 * MiB;
constexpr size_t WS_DLOG = 17 * MiB;
constexpr size_t WS_SSQH = 43 * MiB;
constexpr size_t WS_XN0 = 45 * MiB;
constexpr size_t WS_Z = 109 * MiB;
constexpr size_t WS_GATE = 237 * MiB;
constexpr size_t WS_A2 = 365 * MiB;
constexpr size_t WS_END = 493 * MiB;
constexpr int CW_TMO = 0, CW_CODE = 1, CW_BAR = 4096;

constexpr int RING_OFF = 0, RING_BYTES = 131072;
constexpr int LDSCTL_OFF = RING_BYTES, MISC_OFF = LDSCTL_OFF + 320;
constexpr int RED_OFF = 132 * 1024;
constexpr int RS_OFF = 140 * 1024;
constexpr int LDS_BYTES = 147456;

typedef GAS unsigned gu32;
#define RLX_AGENT __ATOMIC_RELAXED, __HIP_MEMORY_SCOPE_AGENT
#define LDS_WAIT() asm volatile("s_waitcnt lgkmcnt(0)" ::: "memory")
#define VM_WAIT() asm volatile("s_waitcnt vmcnt(0)" ::: "memory")

#define XB_TMO      128
#define XB_XCNT(j)  (256  + 64 * (j))
#define XB_XSUB(j)  (1280 + 64 * (j))
#define XB_XGEN(j)  (2304 + 64 * (j))
#define XB_TOP      3328
#define XB_TOPGEN   3392
#define XCD_BAR_WORDS 3456
#define XB_SPIN_CAP (1u << 18)

__device__ __forceinline__ unsigned xb_ld(unsigned* p)              { return __hip_atomic_load(p, __ATOMIC_RELAXED, __HIP_MEMORY_SCOPE_AGENT); }
__device__ __forceinline__ unsigned xb_add(unsigned* p, unsigned v) { return __hip_atomic_fetch_add(p, v, __ATOMIC_RELAXED, __HIP_MEMORY_SCOPE_AGENT); }
__device__ __forceinline__ unsigned xb_xcc_id() { return (unsigned)__builtin_amdgcn_s_getreg((3 << 11) | 20) & 0xFu; }
#define XB_SPIN(cond, bar) do { unsigned _sp = 0; while (cond) { __builtin_amdgcn_s_sleep(1); \
    if ((++_sp & 255u) == 0u) { if (xb_ld(&(bar)[XB_TMO])) break; if (_sp > XB_SPIN_CAP) { atomicAdd(&(bar)[XB_TMO], 1u); break; } } } } while (0)

struct XcdBarrier { unsigned* bar; unsigned x; volatile LAS unsigned* st; };

__device__ __forceinline__ XcdBarrier xcd_barrier_post(unsigned* bar, volatile LAS unsigned* st) {
    XcdBarrier b; b.bar = bar; b.x = xb_xcc_id(); b.st = st;
    if (threadIdx.x == 0) (void)xb_add(&bar[XB_XCNT(b.x)], 1u);
    return b;
}
__device__ __forceinline__ void xcd_barrier_complete(unsigned* bar, unsigned x, unsigned& nloc, unsigned& nx) {
    const unsigned G = gridDim.x * gridDim.y * gridDim.z;
    unsigned sum, cnt, mine, sp = 0u;
    for (;;) {
        sum = 0u; cnt = 0u; mine = 0u;
#pragma unroll
        for (unsigned j = 0; j < 16; ++j) { const unsigned c = xb_ld(&bar[XB_XCNT(j)]); sum += c; cnt += (c > 0u) ? 1u : 0u; mine = (j == x) ? c : mine; }
        if (sum == G) break;
        __builtin_amdgcn_s_sleep(1);
        if ((++sp & 255u) == 0u) { if (xb_ld(&bar[XB_TMO])) break; if (sp > XB_SPIN_CAP) { atomicAdd(&bar[XB_TMO], 1u); break; } }
    }
    nloc = mine > 0u ? mine : 1u; nx = cnt > 0u ? cnt : 1u;
}
__device__ __forceinline__ void xcd_barrier(const XcdBarrier& b) {
    asm volatile("s_waitcnt vmcnt(0)" ::: "memory");
    __syncthreads();
    if (threadIdx.x == 0) {
        unsigned* bar = b.bar;
        __builtin_amdgcn_s_waitcnt(0);
        unsigned nloc = b.st[0], nx = b.st[1];
        if (nloc == 0u) { xcd_barrier_complete(bar, b.x, nloc, nx); b.st[0] = nloc; b.st[1] = nx; }
        const unsigned old = xb_add(&bar[XB_XSUB(b.x)], 1u);
        const unsigned gen = old / nloc;
        if (old + 1u == (gen + 1u) * nloc) {
            __builtin_amdgcn_fence(__ATOMIC_RELEASE, "agent");
            asm volatile("s_waitcnt vmcnt(0)" ::: "memory");
            const unsigned og = xb_add(&bar[XB_TOP], 1u);
            const unsigned tg = og / nx;
            if (og + 1u == (tg + 1u) * nx) xb_add(&bar[XB_TOPGEN], 1u);
            else XB_SPIN(xb_ld(&bar[XB_TOPGEN]) == tg, bar);
            __builtin_amdgcn_fence(__ATOMIC_ACQUIRE, "agent");
            xb_add(&bar[XB_XGEN(b.x)], 1u);
            asm volatile("s_waitcnt vmcnt(0)" ::: "memory");
        } else {
            XB_SPIN(xb_ld(&bar[XB_XGEN(b.x)]) == gen, bar);
            __builtin_amdgcn_fence(__ATOMIC_ACQUIRE, "agent");
            asm volatile("s_waitcnt vmcnt(0)" ::: "memory");
        }
    }
    __syncthreads();
}

struct Frame {
    LAS unsigned char* lds;
    volatile LAS unsigned* MISC;
    gu32* ctl;
    int tid, lane, wave;
    int vcu, G;
    const float *x, *meta, *normw, *pwin, *pwgrp, *pscale, *pwout, *hwin, *hlb, *honorm, *hwout, *fnw;
    float* out;
    unsigned char* ws;
};
__device__ __forceinline__ float wave_sum(float v) {
#pragma unroll
    for (int o = 1; o < 64; o <<= 1) v += __shfl_xor(v, o);
    return v;
}

__device__ __forceinline__ void p0_transpose_item(const float* W, int ldw, int col0, int K, int Nsub, bf16_t* WT, int row_off, const float* kscale, LAS float* scr, int item, int lane) {
    const int nblk = Nsub / 32, kb = item / nblk, nb = item % nblk, k0 = 64 * kb, n0 = 32 * nb;
#pragma unroll 8
    for (int i = 0; i < 32; ++i) { const int kk = 2 * i + (lane >> 5); float v = W[(size_t)(k0 + kk) * ldw + col0 + n0 + (lane & 31)]; if (kscale) v *= kscale[k0 + kk]; scr[kk * 33 + (lane & 31)] = v; }
    LDS_WAIT(); asm volatile("" ::: "memory");
    const int c = lane & 7;
#pragma unroll
    for (int j = 0; j < 4; ++j) { const int n = (lane >> 3) + 8 * j; const LAS float* s = scr + (8 * c) * 33 + n;
        u32x4 o; o.x = pk2(s[0 * 33], s[1 * 33]); o.y = pk2(s[2 * 33], s[3 * 33]); o.z = pk2(s[4 * 33], s[5 * 33]); o.w = pk2(s[6 * 33], s[7 * 33]);
        *(GAS u32x4*)(WT + (size_t)(row_off + n0 + n) * K + k0 + 8 * c) = o; }
    LDS_WAIT(); asm volatile("" ::: "memory");
}
__device__ __forceinline__ void rms_row_to_bf16(int lane, const float* xrow, const float* w, bf16_t* orow) {
    const GAS f32x4* xr = (const GAS f32x4*)xrow + lane; const GAS f32x4* wr = (const GAS f32x4*)w + lane;
    f32x4 v[4]; float s = 0.f;
#pragma unroll
    for (int j = 0; j < 4; ++j) { v[j] = xr[64 * j]; s += (v[j].x * v[j].x + v[j].y * v[j].y) + (v[j].z * v[j].z + v[j].w * v[j].w); }
    const float rstd = 1.f / sqrtf(wave_sum(s) * (1.f / DM) + EPS);
    GAS unsigned long long* o8 = (GAS unsigned long long*)orow + lane;
#pragma unroll
    for (int j = 0; j < 4; ++j) { const f32x4 ww = wr[64 * j];
        o8[64 * j] = (unsigned long long)pk2(v[j].x * rstd * ww.x, v[j].y * rstd * ww.y) | ((unsigned long long)pk2(v[j].z * rstd * ww.z, v[j].w * rstd * ww.w) << 32); }
}

__device__ __forceinline__ float mini_gemm16(Frame& F, int K, const float* W, int ldw, int ncol) {
    const LAS float* AT = (const LAS float*)(F.lds + RING_OFF); LAS float* red = (LAS float*)(F.lds + RED_OFF);
    const int ks = F.tid >> 4;
    float acc[16];
#pragma unroll
    for (int r = 0; r < 16; ++r) acc[r] = 0.f;
    for (int k = ks; k < K; k += 32) { const float w = W[(size_t)k * ldw + ncol];
        const LAS f32x4* a = (const LAS f32x4*)(AT + k * 16);
#pragma unroll
        for (int q = 0; q < 4; ++q) { const f32x4 av = a[q]; acc[4 * q + 0] += w * av.x; acc[4 * q + 1] += w * av.y; acc[4 * q + 2] += w * av.z; acc[4 * q + 3] += w * av.w; } }
#pragma unroll
    for (int r = 0; r < 16; ++r) { acc[r] += __shfl_xor(acc[r], 16); acc[r] += __shfl_xor(acc[r], 32); }
    if (F.lane < 16) {
#pragma unroll
        for (int r = 0; r < 16; ++r) red[(F.wave * 16 + r) * 16 + F.lane] = acc[r]; }
    __syncthreads();
    float res = 0.f;
    if (F.tid < 256) {
#pragma unroll
        for (int w = 0; w < 8; ++w) res += red[(w * 16 + (F.tid >> 4)) * 16 + (F.tid & 15)]; }
    __syncthreads();
    return res;
}

__device__ __forceinline__ void meta_a(Frame& F) {
    LAS float* rsl = (LAS float*)(F.lds + RS_OFF); LAS float* AT = (LAS float*)(F.lds + RING_OFF);
    for (int r = F.wave; r < 16; r += NWAVES) { float s = 0.f;
        for (int k = F.lane; k < DM; k += 64) { const float v = F.meta[r * DM + k]; s += v * v; }
        s = wave_sum(s); if (F.lane == 0) rsl[r] = 1.f / sqrtf(s * (1.f / DM) + EPS); }
    __syncthreads();
    for (int i = F.tid; i < 16 * DM; i += NWAVES * 64) { const int r = i >> 10, k = i & (DM - 1); AT[k * 16 + r] = F.meta[i] * rsl[r] * F.normw[k]; }
    __syncthreads();
    float* VGM = (float*)(F.ws + WS_VGM);
    for (int bx = F.vcu; bx < 256; bx += F.G) { const int n = bx * 16 + (F.tid & 15);
        const float res = mini_gemm16(F, DM, F.pwin, 4096, n);
        if (F.tid < 256) VGM[(F.tid >> 4) * 4096 + n] = res; }
    __syncthreads();
}
__device__ __forceinline__ void meta_b(Frame& F) {
    LAS float* AT = (LAS float*)(F.lds + RING_OFF); LAS float* zt = (LAS float*)(F.lds + RED_OFF);
    const float* VGM = (const float*)(F.ws + WS_VGM); float* ZM = (float*)(F.ws + WS_ZM); float* A2M = (float*)(F.ws + WS_A2M);
    for (int bx = F.vcu; bx < 128; bx += F.G) { const int g = bx >> 5, n = bx * 16 + (F.tid & 15), d = n & 511;
        for (int i = F.tid; i < 16 * 512; i += NWAVES * 64) { const int r = i >> 9, c = i & 511; AT[c * 16 + r] = VGM[r * 4096 + 512 * g + c]; }
        __syncthreads();
        const float res = mini_gemm16(F, 512, F.pwgrp + (size_t)g * 512 * 512, 512, d);
        if (F.tid < 256) { zt[F.tid] = res; ZM[(F.tid >> 4) * EW + n] = res; ((bf16_t*)(F.ws + WS_ZMB))[(F.tid >> 4) * EW + n] = (bf16_t)f2bf(res); }
        __syncthreads();
        if (F.tid < 256) { const int r = F.tid >> 4, col = F.tid & 15, w = 2 << g, cnt = (r + 1) < w ? (r + 1) : w; float s = 0.f;
            for (int j = 0; j < cnt; ++j) s += zt[(r - j) * 16 + col];
            const float pz = s / (float)cnt - zt[r * 16 + col], gate = VGM[r * 4096 + EW + n];
            A2M[r * EW + n] = pz * F.pscale[n] * (gate / (1.f + expf(-gate))); }
        __syncthreads();
    }
}
__device__ __forceinline__ void meta_c(Frame& F) {
    LAS float* AT = (LAS float*)(F.lds + RING_OFF);
    const float* A2M = (const float*)(F.ws + WS_A2M); float* H1M = (float*)(F.ws + WS_H1M);
    for (int bx = F.vcu; bx < 64; bx += F.G) { const int n = bx * 16 + (F.tid & 15);
        for (int i = F.tid; i < 16 * EW; i += NWAVES * 64) { const int r = i >> 11, c = i & (EW - 1); AT[c * 16 + r] = A2M[i]; }
        __syncthreads();
        const float res = mini_gemm16(F, EW, F.pwout, DM, n);
        if (F.tid < 256) { const int r = F.tid >> 4; H1M[r * DM + n] = F.meta[r * DM + n] + res; }
        __syncthreads();
    }
}
__device__ __forceinline__ void meta_d(Frame& F) {
    LAS float* rsl = (LAS float*)(F.lds + RS_OFF); LAS float* AT = (LAS float*)(F.lds + RING_OFF);
    const float* H1M = (const float*)(F.ws + WS_H1M); const float* LB = (const float*)(F.ws + WS_LB); float* FM = (float*)(F.ws + WS_FM); float* IM = (float*)(F.ws + WS_IM);
    for (int r = F.wave; r < 16; r += NWAVES) { float s = 0.f;
        for (int k = F.lane; k < DM; k += 64) { const float v = H1M[r * DM + k]; s += v * v; }
        s = wave_sum(s); if (F.lane == 0) rsl[r] = 1.f / sqrtf(s * (1.f / DM) + EPS); }
    __syncthreads();
    for (int i = F.tid; i < 16 * DM; i += NWAVES * 64) { const int r = i >> 10, k = i & (DM - 1); AT[k * 16 + r] = H1M[i] * rsl[r] * F.normw[DM + k]; }
    __syncthreads();
    for (int bx = F.vcu; bx < 256; bx += F.G) { const int np = bx * 16 + (F.tid & 15);
        const float res = mini_gemm16(F, DM, F.hwin, 8192, EW + np);
        if (F.tid < 256) { const int r = F.tid >> 4;
            if (np < EW) { const float l = LB[np]; FM[r * EW + np] = l + (1.f - l) / (1.f + expf(-res)); }
            else IM[r * EW + np - EW] = res; } }
    __syncthreads();
}
__device__ __forceinline__ void meta_e(Frame& F) {
    const float* FM = (const float*)(F.ws + WS_FM); const float* IM = (const float*)(F.ws + WS_IM); float* SM = (float*)(F.ws + WS_SMETA);
    for (int e = F.vcu * (NWAVES * 64) + F.tid; e < NHEAD * HD * HD; e += F.G * NWAVES * 64) { const int h = e >> 14, k = (e >> 7) & 127, v = e & 127; float S = 0.f;
        for (int s = 0; s < NMETA; ++s) { const float f = FM[s * EW + h * HD + k]; S = f * S + (1.f - f) * IM[s * EW + h * HD + v]; }
        SM[e] = S; }
}

__device__ __forceinline__ void p0_prologue(Frame& F) {
    LAS float* scr = (LAS float*)(F.lds + RING_OFF + F.wave * 16384);
    const int gw = F.vcu * NWAVES + F.wave, NGW = F.G * NWAVES;
    bf16_t* W1T = (bf16_t*)(F.ws + WS_W1T); bf16_t* WGT = (bf16_t*)(F.ws + WS_WGT); bf16_t* WINV = (bf16_t*)(F.ws + WS_WINV); bf16_t* WO0T = (bf16_t*)(F.ws + WS_WO0T);
    bf16_t* HWIN = (bf16_t*)(F.ws + WS_HWIN); bf16_t* HWOUT = (bf16_t*)(F.ws + WS_HWOUT); bf16_t* XN0 = (bf16_t*)(F.ws + WS_XN0);
    constexpr int I_GATE = (DM / 64) * (EW / 32), I_WG1 = (512 / 64) * (512 / 32), I_WG = 4 * I_WG1, I_WO0 = (EW / 64) * (DM / 32), I_HWIN = (DM / 64) * (8192 / 32), I_HWOUT = I_WO0;
    constexpr int NITEMS = I_GATE + I_WG + I_WO0 + I_HWIN + I_HWOUT;
    for (int it = gw; it < NITEMS; it += NGW) {
        int r = it;
        if (r < I_GATE) { p0_transpose_item(F.pwin, 4096, EW, DM, EW, W1T, EW, nullptr, scr, r, F.lane); continue; } r -= I_GATE;
        if (r < I_WG) { const int g = r / I_WG1; p0_transpose_item(F.pwgrp + (size_t)g * 512 * 512, 512, 0, 512, 512, WGT + (size_t)g * 512 * 512, 0, nullptr, scr, r % I_WG1, F.lane); continue; } r -= I_WG;
        if (r < I_WO0) { p0_transpose_item(F.pwout, DM, 0, EW, DM, WO0T, 0, nullptr, scr, r, F.lane); continue; } r -= I_WO0;
        if (r < I_HWIN) { p0_transpose_item(F.hwin, 8192, 0, DM, 8192, HWIN, 0, F.normw + DM, scr, r, F.lane); continue; } r -= I_HWIN;
        p0_transpose_item(F.hwout, DM, 0, EW, DM, HWOUT, 0, nullptr, scr, r, F.lane);
    }
    for (int idx = F.vcu * (NWAVES * 64) + F.tid; idx < DM * EW / 8; idx += F.G * NWAVES * 64) { const int k = idx >> 8, c8 = idx & 255;
        const f32x4 a = *(const f32x4*)(F.pwin + (size_t)k * 4096 + c8 * 8), b = *(const f32x4*)(F.pwin + (size_t)k * 4096 + c8 * 8 + 4);
        u32x4 o; o.x = pk2(a.x, a.y); o.y = pk2(a.z, a.w); o.z = pk2(b.x, b.y); o.w = pk2(b.z, b.w);
        *(u32x4*)(WINV + (size_t)k * EW + c8 * 8) = o; }
    { float* LB = (float*)(F.ws + WS_LB);
      for (int c = F.vcu * (NWAVES * 64) + F.tid; c < EW; c += F.G * NWAVES * 64) LB[c] = 1.f / (1.f + expf(F.hlb[c] - F.hlb[EW + c])); }
    for (int m = gw; m < MROWS; m += NGW) rms_row_to_bf16(F.lane, F.x + (size_t)m * DM, F.normw, XN0 + (size_t)m * DM);
}

__device__ __forceinline__ float unpk(const u32x4& v, int e) { const unsigned w = v[e >> 1]; return (e & 1) ? bf_hi(w) : bf_lo(w); }
template <int W> __device__ __forceinline__ void pool_run(const bf16_t* Z, const bf16_t* Gt, bf16_t* A2, const bf16_t* ZMB, const float* scale, int row0, int c0) {
    const int s0 = row0 & (SEQ - 1);
    u32x4 ring[W]; float S[8], sc[8];
#pragma unroll
    for (int e = 0; e < 8; ++e) { S[e] = 0.f; sc[e] = scale[c0 + e]; }
    const bf16_t* hsrc = (s0 != 0 ? Z + (size_t)(row0 - W) * EW : ZMB + (size_t)(NMETA - W) * EW) + c0;
#pragma unroll
    for (int j = 0; j < W; ++j) { const u32x4 p = *(const u32x4*)(hsrc + (size_t)j * EW);
        ring[j] = p;
#pragma unroll
        for (int e = 0; e < 8; ++e) S[e] += unpk(p, e); }
    constexpr float invW = 1.0f / (float)W;
#pragma unroll W >= 8 ? 1 : 8 / W
    for (int r0 = 0; r0 < 64; r0 += W) {
#pragma unroll
        for (int j = 0; j < W; ++j) { const size_t off = (size_t)(row0 + r0 + j) * EW + c0;
            const u32x4 x = *(const u32x4*)(Z + off), gt = *(const u32x4*)(Gt + off); float o[8];
#pragma unroll
            for (int e = 0; e < 8; ++e) { const float xe = unpk(x, e); S[e] += xe - unpk(ring[j], e); o[e] = (S[e] * invW - xe) * sc[e] * fast_silu(unpk(gt, e)); }
            ring[j] = x;
            u32x4 w; w.x = pk2(o[0], o[1]); w.y = pk2(o[2], o[3]); w.z = pk2(o[4], o[5]); w.w = pk2(o[6], o[7]);
            *(u32x4*)(A2 + off) = w; }
    }
}
__device__ __forceinline__ void pool_phase(Frame& F) {
    const bf16_t* Z = (const bf16_t*)(F.ws + WS_Z); const bf16_t* Gt = (const bf16_t*)(F.ws + WS_GATE); bf16_t* A2 = (bf16_t*)(F.ws + WS_A2); const bf16_t* ZM = (const bf16_t*)(F.ws + WS_ZMB);
    for (int item = F.vcu * (NWAVES * 64) + F.tid; item < (MROWS / 64) * (EW / 8); item += F.G * NWAVES * 64) {
        const int cg = item & 255, rr = item >> 8, grp = __builtin_amdgcn_readfirstlane(cg >> 6), c0 = cg * 8, row0 = rr * 64;
        if (grp == 0) pool_run<2>(Z, Gt, A2, ZM, F.pscale, row0, c0);
        else if (grp == 1) pool_run<4>(Z, Gt, A2, ZM, F.pscale, row0, c0);
        else if (grp == 2) pool_run<8>(Z, Gt, A2, ZM, F.pscale, row0, c0);
        else pool_run<16>(Z, Gt, A2, ZM, F.pscale, row0, c0);
    }
}

constexpr int HSEG = 4;
__host__ __device__ constexpr int hseg_start(int s) { return s == 0 ? 0 : (s == 1 ? 2048 : (s == 2 ? 4096 : (s == 3 ? 6144 : SEQ))); }
constexpr int QT_STRIDE = 272, KT_STRIDE = 288;
constexpr int H_QT = 0, H_KT = H_QT + 32 * QT_STRIDE, H_VT = H_KT + 32 * KT_STRIDE, H_OT = H_VT + 32 * KT_STRIDE, H_WT = H_OT + 32 * QT_STRIDE, H_EB = H_WT + 8 * 128 * 4, H_END = H_EB + 128 * 4;
typedef short s16x4 __attribute__((ext_vector_type(4)));
typedef __bf16 bf16x2_t __attribute__((ext_vector_type(2)));
__device__ __forceinline__ unsigned cvtpk(float lo, float hi) { const f32x2 v = {lo, hi}; const bf16x2_t b = __builtin_convertvector(v, bf16x2_t); return __builtin_bit_cast(unsigned, b); }
__device__ __forceinline__ bf16x8 mk8(unsigned a, unsigned b, unsigned c, unsigned d) { const u32x4 v = {a, b, c, d}; return __builtin_bit_cast(bf16x8, v); }
__device__ __forceinline__ s16x4 tr_read(const LAS unsigned char* p) { return __builtin_amdgcn_ds_read_tr16_b64_v4i16((LAS s16x4*)p); }
__device__ __forceinline__ bf16x8 cat44(s16x4 a, s16x4 b) { return __builtin_shufflevector(a, b, 0, 1, 2, 3, 4, 5, 6, 7); }

template <bool PASSB> __device__ __forceinline__ void hgrn_pass(Frame& F) {
    bf16_t* Q = (bf16_t*)(F.ws + WS_Z); const bf16_t* Gl = (const bf16_t*)(F.ws + WS_GATE); const bf16_t* V = (const bf16_t*)(F.ws + WS_A2);
    float* ssqh = (float*)(F.ws + WS_SSQH); const float* SM = (const float*)(F.ws + WS_SMETA); float* LS = (float*)(F.ws + WS_LSEG); float* DL = (float*)(F.ws + WS_DLOG);
    LAS unsigned char* L = F.lds;
    const int w = F.wave, lane = F.lane, r16 = lane & 15, q4 = lane >> 4;
    const int t = F.tid >> 4, cg = F.tid & 15;
    for (int task = F.vcu; task < BATCH * NHEAD * HSEG; task += F.G) {
        const int seg = task & (HSEG - 1), bh = task >> 2, b = bh >> 4, h = bh & 15;
        if (!PASSB && seg == HSEG - 1) continue;
        const int s_beg = hseg_start(seg), nblk = (hseg_start(seg + 1) - s_beg) / 32;
        f32x4 S[8];
        if (PASSB) {
#pragma unroll
            for (int cb = 0; cb < 8; ++cb)
#pragma unroll
                for (int r = 0; r < 4; ++r) S[cb][r] = SM[(size_t)(h * HD + 16 * cb + 4 * q4 + r) * HD + 16 * w + r16];
            for (int i = 0; i < seg; ++i) { const float* Li = LS + (size_t)(bh * HSEG + i) * HD * HD; const float* Di = DL + (size_t)(bh * HSEG + i) * HD;
#pragma unroll
                for (int cb = 0; cb < 8; ++cb)
#pragma unroll
                    for (int r = 0; r < 4; ++r) { const int c = 16 * cb + 4 * q4 + r; S[cb][r] = expf(Di[c]) * S[cb][r] + Li[(size_t)c * HD + 16 * w + r16]; } }
        } else {
#pragma unroll
            for (int cb = 0; cb < 8; ++cb) S[cb] = (f32x4){0.f, 0.f, 0.f, 0.f};
        }
        float dl[8];
#pragma unroll
        for (int e = 0; e < 8; ++e) dl[e] = 0.f;
        size_t goff = ((size_t)b * SEQ + s_beg + t) * EW + h * HD + 8 * cg;
        u32x4 qv = (u32x4){0u, 0u, 0u, 0u}, gv = *(const u32x4*)(Gl + goff), vv = *(const u32x4*)(V + goff);
        if (PASSB) qv = *(const u32x4*)(Q + goff);
        size_t ooff = goff;
        for (int blk = 0; blk <= nblk; ++blk) {
            float c[8], g[8];
            if (blk < nblk) {
#pragma unroll
                for (int e = 0; e < 8; ++e) { g[e] = unpk(gv, e); float x = g[e]; float y = __shfl_up(x, 16); x = lane >= 16 ? x + y : x; y = __shfl_up(x, 32); x = lane >= 32 ? x + y : x; c[e] = x; }
                if (q4 == 3) { LAS f32x4* wt = (LAS f32x4*)(L + H_WT + (w * 128 + 8 * cg) * 4); wt[0] = (f32x4){c[0], c[1], c[2], c[3]}; wt[1] = (f32x4){c[4], c[5], c[6], c[7]}; }
            }
            __syncthreads();
            if (PASSB && blk > 0) {
                const u32x4 ov = *(const LAS u32x4*)(L + H_OT + t * QT_STRIDE + cg * 16);
                float ss = 0.f;
#pragma unroll
                for (int e = 0; e < 8; ++e) { const float x = unpk(ov, e); ss += x * x; }
                ss += __shfl_xor(ss, 1); ss += __shfl_xor(ss, 2); ss += __shfl_xor(ss, 4); ss += __shfl_xor(ss, 8);
                *(u32x4*)(Q + ooff) = ov;
                if (cg == 0) ssqh[(ooff / EW) * NHEAD + h] = ss;
            }
            if (blk == nblk) break;
            ooff = goff;
            {
                float off[8];
#pragma unroll
                for (int e = 0; e < 8; ++e) off[e] = 0.f;
#pragma unroll
                for (int ww = 0; ww < 7; ++ww) if (ww < w) { const LAS f32x4* wt = (const LAS f32x4*)(L + H_WT + (ww * 128 + 8 * cg) * 4); const f32x4 a = wt[0], bq = wt[1];
                    off[0] += a.x; off[1] += a.y; off[2] += a.z; off[3] += a.w; off[4] += bq.x; off[5] += bq.y; off[6] += bq.z; off[7] += bq.w; }
                float kt[8], qt[8], eb[8];
#pragma unroll
                for (int e = 0; e < 8; ++e) { const float Bp = off[e] + c[e]; const float f = fast_exp(g[e]); eb[e] = fast_exp(Bp); const float enb = fast_exp(fminf(-Bp, 80.f));
                    kt[e] = (1.0f - f) * enb; qt[e] = unpk(qv, e) * eb[e]; if (!PASSB) dl[e] += (t == 31) ? Bp : 0.f; }
                *(LAS u32x4*)(L + H_KT + t * KT_STRIDE + cg * 16) = (u32x4){cvtpk(kt[0], kt[1]), cvtpk(kt[2], kt[3]), cvtpk(kt[4], kt[5]), cvtpk(kt[6], kt[7])};
                *(LAS u32x4*)(L + H_VT + t * KT_STRIDE + cg * 16) = vv;
                if (PASSB) *(LAS u32x4*)(L + H_QT + t * QT_STRIDE + cg * 16) = (u32x4){cvtpk(qt[0], qt[1]), cvtpk(qt[2], qt[3]), cvtpk(qt[4], qt[5]), cvtpk(qt[6], qt[7])};
                if (t == 31) { LAS f32x4* ebp = (LAS f32x4*)(L + H_EB + 8 * cg * 4); ebp[0] = (f32x4){eb[0], eb[1], eb[2], eb[3]}; ebp[1] = (f32x4){eb[4], eb[5], eb[6], eb[7]}; }
            }
            __syncthreads();
            if (blk + 1 < nblk) { goff += (size_t)32 * EW; gv = *(const u32x4*)(Gl + goff); vv = *(const u32x4*)(V + goff); if (PASSB) qv = *(const u32x4*)(Q + goff); }
            const int trq = r16 >> 2, trp = r16 & 3;
            if (PASSB) {
                bf16x8 Sb[4];
#pragma unroll
                for (int ks = 0; ks < 4; ++ks) Sb[ks] = mk8(cvtpk(S[2 * ks][0], S[2 * ks][1]), cvtpk(S[2 * ks][2], S[2 * ks][3]), cvtpk(S[2 * ks + 1][0], S[2 * ks + 1][1]), cvtpk(S[2 * ks + 1][2], S[2 * ks + 1][3]));
                f32x4 o[2] = {(f32x4){0.f, 0.f, 0.f, 0.f}, (f32x4){0.f, 0.f, 0.f, 0.f}};
#pragma unroll
                for (int tb = 0; tb < 2; ++tb)
#pragma unroll
                    for (int ks = 0; ks < 4; ++ks) { const LAS unsigned char* qa = L + H_QT + (16 * tb + r16) * QT_STRIDE + (32 * ks + 4 * q4) * 2;
                        const u32x2 a0 = *(const LAS u32x2*)qa, a1 = *(const LAS u32x2*)(qa + 32);
                        o[tb] = __builtin_amdgcn_mfma_f32_16x16x32_bf16(mk8(a0.x, a0.y, a1.x, a1.y), Sb[ks], o[tb], 0, 0, 0); }
                f32x4 at00 = (f32x4){0.f, 0.f, 0.f, 0.f}, at01 = at00, at11 = at00;
#pragma unroll
                for (int ks = 0; ks < 4; ++ks) {
                    const bf16x8 k0 = *(const LAS bf16x8*)(L + H_KT + r16 * KT_STRIDE + (32 * ks + 8 * q4) * 2), k1 = *(const LAS bf16x8*)(L + H_KT + (16 + r16) * KT_STRIDE + (32 * ks + 8 * q4) * 2);
                    const bf16x8 q0 = *(const LAS bf16x8*)(L + H_QT + r16 * QT_STRIDE + (32 * ks + 8 * q4) * 2), q1 = *(const LAS bf16x8*)(L + H_QT + (16 + r16) * QT_STRIDE + (32 * ks + 8 * q4) * 2);
                    at00 = __builtin_amdgcn_mfma_f32_16x16x32_bf16(k0, q0, at00, 0, 0, 0);
                    at01 = __builtin_amdgcn_mfma_f32_16x16x32_bf16(k0, q1, at01, 0, 0, 0);
                    at11 = __builtin_amdgcn_mfma_f32_16x16x32_bf16(k1, q1, at11, 0, 0, 0); }
#pragma unroll
                for (int r = 0; r < 4; ++r) if (4 * q4 + r > r16) { at00[r] = 0.f; at11[r] = 0.f; }
                const bf16x8 Bv = cat44(tr_read(L + H_VT + (4 * q4 + trq) * KT_STRIDE + (16 * w + 4 * trp) * 2), tr_read(L + H_VT + (16 + 4 * q4 + trq) * KT_STRIDE + (16 * w + 4 * trp) * 2));
                o[0] = __builtin_amdgcn_mfma_f32_16x16x32_bf16(mk8(cvtpk(at00[0], at00[1]), cvtpk(at00[2], at00[3]), 0u, 0u), Bv, o[0], 0, 0, 0);
                o[1] = __builtin_amdgcn_mfma_f32_16x16x32_bf16(mk8(cvtpk(at01[0], at01[1]), cvtpk(at01[2], at01[3]), cvtpk(at11[0], at11[1]), cvtpk(at11[2], at11[3])), Bv, o[1], 0, 0, 0);
#pragma unroll
                for (int tb = 0; tb < 2; ++tb)
#pragma unroll
                    for (int r = 0; r < 4; ++r) *(LAS bf16_t*)(L + H_OT + (16 * tb + 4 * q4 + r) * QT_STRIDE + (16 * w + r16) * 2) = (bf16_t)f2bf(o[tb][r]);
            }
            {
                const bf16x8 Bs = cat44(tr_read(L + H_VT + (8 * q4 + trq) * KT_STRIDE + (16 * w + 4 * trp) * 2), tr_read(L + H_VT + (8 * q4 + 4 + trq) * KT_STRIDE + (16 * w + 4 * trp) * 2));
#pragma unroll
                for (int cb = 0; cb < 8; ++cb) {
                    const bf16x8 Ak = cat44(tr_read(L + H_KT + (8 * q4 + trq) * KT_STRIDE + (16 * cb + 4 * trp) * 2), tr_read(L + H_KT + (8 * q4 + 4 + trq) * KT_STRIDE + (16 * cb + 4 * trp) * 2));
                    S[cb] = __builtin_amdgcn_mfma_f32_16x16x32_bf16(Ak, Bs, S[cb], 0, 0, 0); }
#pragma unroll
                for (int cb = 0; cb < 8; ++cb) { const f32x4 ebv = *(const LAS f32x4*)(L + H_EB + (16 * cb + 4 * q4) * 4); S[cb] = S[cb] * ebv; }
            }
        }
        if (!PASSB) {
            float* Lo = LS + (size_t)(bh * HSEG + seg) * HD * HD;
#pragma unroll
            for (int cb = 0; cb < 8; ++cb)
#pragma unroll
                for (int r = 0; r < 4; ++r) Lo[(size_t)(16 * cb + 4 * q4 + r) * HD + 16 * w + r16] = S[cb][r];
            if (t == 31) { float* Do = DL + (size_t)(bh * HSEG + seg) * HD + 8 * cg;
#pragma unroll
                for (int e = 0; e < 8; ++e) Do[e] = dl[e]; }
        }
        __syncthreads();
    }
}

__device__ __forceinline__ void final_norm(Frame& F) {
    const int gw = F.vcu * NWAVES + F.wave, NGW = F.G * NWAVES;
    for (int m = gw; m < MROWS; m += NGW) {
        GAS f32x4* xr = (GAS f32x4*)(F.out + (size_t)m * DM) + F.lane; const GAS f32x4* wr = (const GAS f32x4*)F.fnw + F.lane;
        f32x4 v[4]; float s = 0.f;
#pragma unroll
        for (int j = 0; j < 4; ++j) { v[j] = xr[64 * j]; s += (v[j].x * v[j].x + v[j].y * v[j].y) + (v[j].z * v[j].z + v[j].w * v[j].w); }
        const float rstd = 1.f / sqrtf(wave_sum(s) * (1.f / DM) + EPS);
#pragma unroll
        for (int j = 0; j < 4; ++j) { const f32x4 ww = wr[64 * j]; xr[64 * j] = (f32x4){v[j].x * rstd * ww.x, v[j].y * rstd * ww.y, v[j].z * rstd * ww.z, v[j].w * rstd * ww.w}; }
    }
}

struct Args { const float* in[12]; float* out; unsigned char* ws; int ph_lo, ph_hi; };
__global__ void __launch_bounds__(NWAVES * 64, 2) trunk_fwd(Args args) {
    extern __shared__ __attribute__((aligned(16))) unsigned char lds[];
    Frame F;
    F.lds = (LAS unsigned char*)lds;
    F.MISC = (volatile LAS unsigned*)(F.lds + MISC_OFF);
    F.tid = threadIdx.x; F.lane = F.tid & 63; F.wave = __builtin_amdgcn_readfirstlane(F.tid >> 6);
    F.G = gridDim.x; { const int bx = blockIdx.x; F.vcu = (F.G % 8 == 0) ? (bx % 8) * (F.G / 8) + bx / 8 : bx; }
    F.ws = args.ws; F.ctl = (gu32*)(args.ws + WS_CTL);
    F.x = args.in[0]; F.meta = args.in[1]; F.normw = args.in[2]; F.pwin = args.in[3]; F.pwgrp = args.in[4]; F.pscale = args.in[5]; F.pwout = args.in[6];
    F.hwin = args.in[7]; F.hlb = args.in[8]; F.honorm = args.in[9]; F.hwout = args.in[10]; F.fnw = args.in[11]; F.out = args.out;
    for (int u = F.tid; u < (LDS_BYTES - LDSCTL_OFF) / 4; u += NWAVES * 64) ((LAS unsigned*)(F.lds + LDSCTL_OFF))[u] = 0u;
    __syncthreads();
    XcdBarrier bar; bar.bar = (unsigned*)(F.ctl + CW_BAR); bar.x = 0; bar.st = nullptr;
    if (MK_N_LAUNCHES == 1) bar = xcd_barrier_post((unsigned*)(F.ctl + CW_BAR), F.MISC + 8);
    const int lo = args.ph_lo, hi = args.ph_hi;
#define IN(k) (lo <= (k) && (k) < hi)
#define SEAM(k) do { if (IN(k) && IN((k) + 1)) xcd_barrier(bar); } while (0)
    bf16_t* const W1T = (bf16_t*)(F.ws + WS_W1T); bf16_t* const WGT = (bf16_t*)(F.ws + WS_WGT); bf16_t* const WINV = (bf16_t*)(F.ws + WS_WINV); bf16_t* const WO0T = (bf16_t*)(F.ws + WS_WO0T);
    bf16_t* const HWIN = (bf16_t*)(F.ws + WS_HWIN); bf16_t* const HWOUT = (bf16_t*)(F.ws + WS_HWOUT);
    bf16_t* const XN0 = (bf16_t*)(F.ws + WS_XN0); bf16_t* const H1B = XN0; bf16_t* const ZB = (bf16_t*)(F.ws + WS_Z); bf16_t* const GB = (bf16_t*)(F.ws + WS_GATE); bf16_t* const A2B = (bf16_t*)(F.ws + WS_A2);
    float* const SSQ1 = (float*)(F.ws + WS_SSQ1); float* const SSQH = (float*)(F.ws + WS_SSQH); const float* const LB = (const float*)(F.ws + WS_LB);

    if (IN(0)) { meta_a(F); p0_prologue(F); }
    SEAM(0);
    if (IN(1)) {
        meta_b(F);
        pg8::Gemm g{WGT, WINV}; pg8::GroupOrder S{2, 4, 4, F.G, (int)blockIdx.x};
        pg8::EpiBf16Plain E{W1T, DM, (size_t)512 * DM, 0, 0};
        pg8::gemm_phase<pg8::EpiBf16Plain, pg8::GroupOrder, false, true, 512, 512, EW, 512 * 512, 512>(F.lds + RING_OFF, g, S, E);
    }
    SEAM(1);
    if (IN(2)) {
        meta_c(F);
        pg8::Gemm g{XN0, W1T}; pg8::StaticOrder S; S.init(MROWS, 4096, F.G, (int)blockIdx.x);
        pg8::EpiBf16Plain E{ZB, EW, 0, EW, (size_t)(WS_GATE - WS_Z) / 2};
        pg8::gemm_phase<pg8::EpiBf16Plain, pg8::StaticOrder, true, true, DM, DM, DM>(F.lds + RING_OFF, g, S, E);
    }
    SEAM(2);
    if (IN(3)) { meta_d(F); pool_phase(F); }
    SEAM(3);
    if (IN(4)) {
        meta_e(F);
        pg8::Gemm g{A2B, WO0T}; pg8::StaticOrder S; S.init(MROWS, DM, F.G, (int)blockIdx.x);
        pg8::EpiResid E{F.x, F.out, H1B, SSQ1};
        pg8::gemm_phase<pg8::EpiResid, pg8::StaticOrder, true, true, EW, EW, EW>(F.lds + RING_OFF, g, S, E);
    }
    SEAM(4);
    if (IN(5)) {
        pg8::Gemm g{H1B, HWIN}; pg8::StaticOrder S; S.init(MROWS, 6144, F.G, (int)blockIdx.x);
        static_assert(WS_GATE - WS_Z == WS_A2 - WS_GATE, "Q, G, V equally spaced"); pg8::EpiHgrn E{SSQ1, LB, ZB, (size_t)(WS_GATE - WS_Z) / 2};
        pg8::gemm_phase<pg8::EpiHgrn, pg8::StaticOrder, true, true, DM, DM, DM>(F.lds + RING_OFF, g, S, E);
    }
    SEAM(5);
    if (IN(6)) hgrn_pass<false>(F);
    SEAM(6);
    if (IN(7)) hgrn_pass<true>(F);
    SEAM(7);
    if (IN(8)) {
        pg8::Gemm g{H1B, HWIN + (size_t)6144 * DM}; pg8::StaticOrder S; S.init(MROWS, EW, F.G, (int)blockIdx.x);
        pg8::EpiGate E{SSQ1, SSQH, F.honorm, ZB};
        pg8::gemm_phase<pg8::EpiGate, pg8::StaticOrder, true, true, DM, DM, DM>(F.lds + RING_OFF, g, S, E);
    }
    SEAM(8);
    if (IN(9)) {
        pg8::Gemm g{ZB, HWOUT}; pg8::StaticOrder S; S.init(MROWS, DM, F.G, (int)blockIdx.x);
        pg8::EpiResid E{F.out, F.out, nullptr, nullptr};
        pg8::gemm_phase<pg8::EpiResid, pg8::StaticOrder, true, true, EW, EW, EW>(F.lds + RING_OFF, g, S, E);
    }
    SEAM(9);
    if (IN(10)) final_norm(F);
#undef IN
#undef SEAM
}

extern "C" void kernel_launch(void* const* d_in, const int* in_sizes, int n_in, void* d_out, int out_size, void* d_ws, size_t ws_size, hipStream_t stream) {
    static int grid = 0;
    if (grid == 0) {
        if (n_in != 12 || in_sizes[0] != MROWS * DM || out_size != MROWS * DM || ws_size < WS_END) { fprintf(stderr, "kernel_launch: unexpected shapes (n_in %d, in0 %d, out %d, ws %zu); nothing launched\n", n_in, n_in > 0 ? in_sizes[0] : -1, out_size, ws_size); grid = -1; return; }
        int dev = 0, cus = 0, per_cu = 0;
        if (hipGetDevice(&dev) != hipSuccess || hipDeviceGetAttribute(&cus, hipDeviceAttributeMultiprocessorCount, dev) != hipSuccess) { fprintf(stderr, "kernel_launch: device query failed\n"); grid = -1; return; }
        if (hipFuncSetAttribute((const void*)trunk_fwd, hipFuncAttributeMaxDynamicSharedMemorySize, LDS_BYTES) != hipSuccess) { fprintf(stderr, "kernel_launch: hipFuncSetAttribute failed\n"); grid = -1; return; }
        if (hipOccupancyMaxActiveBlocksPerMultiprocessor(&per_cu, (const void*)trunk_fwd, NWAVES * 64, LDS_BYTES) != hipSuccess || per_cu < 1)
            fprintf(stderr, "kernel_launch: note: occupancy query reports %d workgroups per CU\n", per_cu);
        (void)hipGetLastError();
        grid = cus;
    }
    if (grid < 0) return;
    if (hipMemsetAsync((char*)d_ws + WS_CTL, 0, CTL_ZERO_BYTES, stream) != hipSuccess) { fprintf(stderr, "kernel_launch: hipMemsetAsync failed\n"); return; }
    Args a{};
    for (int i = 0; i < 12; ++i) a.in[i] = (const float*)d_in[i];
    a.out = (float*)d_out; a.ws = (unsigned char*)d_ws;
#if MK_N_LAUNCHES == 1
    a.ph_lo = 0; a.ph_hi = N_PHASES;
    hipLaunchKernelGGL(trunk_fwd, dim3(grid), dim3(NWAVES * 64), LDS_BYTES, stream, a);
#else
    for (int p = 0; p < N_PHASES; ++p) { a.ph_lo = p; a.ph_hi = p + 1; hipLaunchKernelGGL(trunk_fwd, dim3(grid), dim3(NWAVES * 64), LDS_BYTES, stream, a); }
#endif
    const hipError_t le = hipPeekAtLastError();
    if (le != hipSuccess) fprintf(stderr, "kernel_launch: launch failed: %s\n", hipGetErrorName(le));
}
```

```cpp
#include <hip/hip_runtime.h>
#include <cstdio>
#include <cstdint>

#define LAS __attribute__((address_space(3)))
#define GAS __attribute__((address_space(1)))
typedef unsigned short bf16_t;
typedef short bf16x8 __attribute__((ext_vector_type(8)));
typedef float f32x4 __attribute__((ext_vector_type(4)));
typedef float f32x2 __attribute__((ext_vector_type(2)));
typedef unsigned u32x4 __attribute__((ext_vector_type(4)));
typedef unsigned u32x2 __attribute__((ext_vector_type(2)));

constexpr int BATCH = 4, SEQ = 8192, DM = 1024, MROWS = BATCH * SEQ, EW = 2048, NMETA = 16, NHEAD = 16, HD = 128;
constexpr float EPS = 1e-6f;
constexpr int NWAVES = 8;

__device__ __forceinline__ unsigned f2bf(float f) { unsigned u = __builtin_bit_cast(unsigned, f); return (u + 0x7fffu + ((u >> 16) & 1u)) >> 16; }
__device__ __forceinline__ unsigned pk2(float lo, float hi) { return f2bf(lo) | (f2bf(hi) << 16); }
__device__ __forceinline__ float bf_lo(unsigned w) { return __builtin_bit_cast(float, w << 16); }
__device__ __forceinline__ float bf_hi(unsigned w) { return __builtin_bit_cast(float, w & 0xffff0000u); }
__device__ __forceinline__ float fast_sigmoid(float x) { return __builtin_amdgcn_rcpf(1.0f + __builtin_amdgcn_exp2f(-1.44269504089f * x)); }
__device__ __forceinline__ float fast_silu(float x) { return x * fast_sigmoid(x); }
__device__ __forceinline__ float fast_exp(float x) { return __builtin_amdgcn_exp2f(1.44269504089f * x); }

namespace pg8 {
#define PG8_LAS __attribute__((address_space(3)))
constexpr int BM = 256, BK = 64, HALF = 128, HTB = HALF * BK * 2  , STAGE_BYTES = 8 * HTB, NXCD = 8, WGM = 8;

__host__ __device__ __forceinline__ int lds_byte(int r, int c) { const int st = (r >> 4) * 2 + (c >> 5), rr = r & 15, cc = c & 31, ob = rr * 64 + cc * 2; return st * 1024 + (ob ^ (((ob >> 9) & 1) << 5)); }
__host__ __device__ __forceinline__ void stage_rc(int b, int& R, int& C) { const int st = b / 1024, sb = b % 1024, swz = sb ^ (((sb >> 9) & 1) << 5); R = (st >> 1) * 16 + swz / 64; C = (st & 1) * 32 + (swz % 64) / 2; }
__host__ __device__ __forceinline__ int perm32(int rho) { const int n = rho >> 4, i = rho & 15; return 8 * (i >> 2) + 4 * n + (i & 3); }

struct Unit { int pm, pn, g; };
struct Gemm { const bf16_t* A; const bf16_t* Bt; };

struct StaticOrder {
    int nM, nN, nwg, G, c;
    __host__ __device__ void init(int M, int N, int G_, int c_) { nM = M / BM; nN = N / BM; nwg = nM * nN; G = G_; c = c_; }
    __host__ __device__ bool next(int i, Unit& u) const {
        const long L = (long)i * G + c; if (L >= nwg) return false;
        int wgid = (int)L; { const int q = nwg / NXCD, r = nwg % NXCD, xcd = wgid % NXCD, off = wgid / NXCD; wgid = (xcd < r ? xcd * (q + 1) : r * (q + 1) + (xcd - r) * q) + off; }
        const int nig = WGM * nN, gid = wgid / nig, fm = gid * WGM, gsz = (nM - fm) < WGM ? (nM - fm) : WGM;
        u.pm = fm + ((wgid % nig) % gsz); u.pn = (wgid % nig) / gsz; u.g = 0; return true;
    }
    __device__ __forceinline__ void a_ready(const Unit&) const {}
    __device__ __forceinline__ void done(const Unit&) const {}
};
struct GroupOrder {
    int nM, nN, ngrp, G, c;
    __host__ __device__ bool next(int i, Unit& u) const {
        const long L = (long)i * G + c; if (L >= (long)nM * nN * ngrp) return false;
        const int per = nM * nN; u.g = (int)L / per; const int r = (int)L % per; u.pm = r / nN; u.pn = r % nN; return true;
    }
    __device__ __forceinline__ void a_ready(const Unit&) const {}
    __device__ __forceinline__ void done(const Unit&) const {}
};

__device__ __forceinline__ unsigned cvt_pk_bf16(float lo, float hi) { unsigned r; asm volatile("v_cvt_pk_bf16_f32 %0, %1, %2" : "=v"(r) : "v"(lo), "v"(hi)); return r; }

template <class Epi, class Sched, bool ALIGN_EPI, bool SP2, int KK, int LDA, int LDB, int GA = 0, int GB = 0>
__device__ __forceinline__ void gemm_phase(PG8_LAS unsigned char* lds, const Gemm g, const Sched& S, const Epi& E) {
    const int tid = threadIdx.x, wid = __builtin_amdgcn_readfirstlane(tid >> 6), lane = tid & 63, wr = wid >> 2, wc = wid & 3, fr = lane & 15, fq = lane >> 4;
    constexpr int K = KK, nt = K / BK;
    unsigned voffA[2], voffB[2];
#pragma unroll
    for (int i = 0; i < 2; ++i) { int R, C; stage_rc(tid * 16 + i * 8192, R, C); const int Rb = Epi::PERM ? ((R & ~31) + perm32(R & 31)) : R;
        voffA[i] = (unsigned)(R * LDA + C) * 2u; voffB[i] = (unsigned)(Rb * LDB + C) * 2u; }
    const size_t kstep = (size_t)(BK * 2);
    const size_t hstepA = (size_t)HALF * LDA * 2, hstepB = (size_t)HALF * LDB * 2;
    const size_t tstepA = 2 * hstepA, tstepB = 2 * hstepB;
    const unsigned ldsw = (unsigned)wid * 1024u;
    const int aoff = lds_byte(wr * 64 + fr, fq * 8), boff = lds_byte(wc * 32 + fr, fq * 8);
#define PG8_SA(b, h) (((b) * 2 + (h)) * HTB)
#define PG8_SB(b, h) ((4 + (b) * 2 + (h)) * HTB)
#define PG8_STAGE(bufoff, gbase, voff) do { _Pragma("unroll") for (int _i = 0; _i < 2; ++_i) \
        __builtin_amdgcn_global_load_lds((const unsigned*)((const char*)(gbase) + (voff)[_i]), (PG8_LAS unsigned*)(lds + (bufoff) + ldsw + _i * 8192), 16, 0, 0); } while (0)
#define PG8_LDA(dst, b, h) do { _Pragma("unroll") for (int m = 0; m < 4; ++m) _Pragma("unroll") for (int k = 0; k < 2; ++k) dst[m][k] = *(const PG8_LAS bf16x8*)(lds + PG8_SA(b, h) + aoff + m * 2048 + k * 1024); } while (0)
#define PG8_LDB(dst, b, h) do { _Pragma("unroll") for (int n = 0; n < 2; ++n) _Pragma("unroll") for (int k = 0; k < 2; ++k) dst[n][k] = *(const PG8_LAS bf16x8*)(lds + PG8_SB(b, h) + boff + n * 2048 + k * 1024); } while (0)
#define PG8_MMA(ai, bj, At, Bt) do { __builtin_amdgcn_s_setprio(1); _Pragma("unroll") for (int m = 0; m < 4; ++m) _Pragma("unroll") for (int n = 0; n < 2; ++n) _Pragma("unroll") for (int k = 0; k < 2; ++k) \
        acc[ai][bj][m][n] = __builtin_amdgcn_mfma_f32_16x16x32_bf16(Bt[n][k], At[m][k], acc[ai][bj][m][n], 0, 0, 0); __builtin_amdgcn_s_setprio(0); } while (0)
#define PG8_WAIT_V(n) asm volatile("s_waitcnt vmcnt(" #n ")" ::: "memory")
#define PG8_WAIT_L(n) asm volatile("s_waitcnt lgkmcnt(" #n ")" ::: "memory")
#define PG8_BAR __builtin_amdgcn_s_barrier()
#define PG8_SCHED __builtin_amdgcn_sched_barrier(0)
    Unit cur, nxt; int ui = 0;
    if (!S.next(0, cur)) return;
    f32x4 acc[2][2][4][2];
#pragma unroll
    for (int a = 0; a < 2; ++a)
#pragma unroll
        for (int b = 0; b < 2; ++b)
#pragma unroll
            for (int m = 0; m < 4; ++m)
#pragma unroll
                for (int n = 0; n < 2; ++n) acc[a][b][m][n] = (f32x4){0.f, 0.f, 0.f, 0.f};
    bf16x8 At[4][2], B0[2][2], B1[2][2];
    const char* cA = (const char*)g.A + (size_t)cur.g * (size_t)GA * 2 + (size_t)cur.pm * tstepA; const char* cB = (const char*)g.Bt + (size_t)cur.g * (size_t)GB * 2 + (size_t)cur.pn * tstepB;
    S.a_ready(cur);
    if constexpr (SP2) {
        PG8_STAGE(PG8_SB(0, 0), cB, voffB); PG8_STAGE(PG8_SB(0, 1), cB + hstepB, voffB); PG8_STAGE(PG8_SA(0, 0), cA, voffA); PG8_STAGE(PG8_SA(0, 1), cA + hstepA, voffA);
        if (wr == 1) PG8_BAR;
        PG8_WAIT_V(2); PG8_BAR;
        PG8_STAGE(PG8_SB(1, 0), cB + kstep, voffB); PG8_STAGE(PG8_SA(1, 0), cA + kstep, voffA); PG8_STAGE(PG8_SB(1, 1), cB + hstepB + kstep, voffB);
        PG8_WAIT_V(6); PG8_BAR;
    } else {
        PG8_STAGE(PG8_SB(0, 0), cB, voffB); PG8_STAGE(PG8_SA(0, 0), cA, voffA); PG8_STAGE(PG8_SB(0, 1), cB + hstepB, voffB); PG8_STAGE(PG8_SA(0, 1), cA + hstepA, voffA);
        if (wr == 1) PG8_BAR;
        PG8_WAIT_V(4); PG8_BAR;
        PG8_STAGE(PG8_SB(1, 0), cB + kstep, voffB); PG8_STAGE(PG8_SA(1, 0), cA + kstep, voffA); PG8_STAGE(PG8_SB(1, 1), cB + hstepB + kstep, voffB);
        PG8_WAIT_V(6); PG8_BAR;
    }
    for (;;) {
        const bool has_next = S.next(ui + 1, nxt);
        const char* nA = has_next ? (const char*)g.A + (size_t)nxt.g * (size_t)GA * 2 + (size_t)nxt.pm * tstepA : cA; const char* nB = has_next ? (const char*)g.Bt + (size_t)nxt.g * (size_t)GB * 2 + (size_t)nxt.pn * tstepB : cB;
        for (int t = 0; t < nt; t += 2) {
            const bool last = (t == nt - 2);
            const char* a1 = cA + (size_t)(t + 1) * kstep;
            const char* a2 = last ? nA : cA + (size_t)(t + 2) * kstep; const char* b2 = last ? nB : cB + (size_t)(t + 2) * kstep;
            const char* a3 = a2 + kstep; const char* b3 = b2 + kstep;
            if (last && has_next) S.a_ready(nxt);
            if constexpr (SP2) {
            PG8_LDB(B0, 0, 0); PG8_LDB(B1, 0, 1); PG8_SCHED; PG8_LDA(At, 0, 0); PG8_STAGE(PG8_SA(1, 1), a1 + hstepA, voffA);
            PG8_WAIT_V(8); PG8_WAIT_L(0); PG8_BAR; PG8_MMA(0, 0, At, B0); PG8_MMA(0, 1, At, B1); PG8_BAR; PG8_SCHED;
            PG8_LDA(At, 0, 1); PG8_STAGE(PG8_SB(0, 0), b2, voffB); PG8_STAGE(PG8_SB(0, 1), b2 + hstepB, voffB); PG8_STAGE(PG8_SA(0, 0), a2, voffA);
            PG8_WAIT_V(8); PG8_WAIT_L(0); PG8_BAR; PG8_MMA(1, 0, At, B0); PG8_MMA(1, 1, At, B1); PG8_BAR; PG8_SCHED;
            PG8_LDB(B0, 1, 0); PG8_LDB(B1, 1, 1); PG8_SCHED; PG8_LDA(At, 1, 0); PG8_STAGE(PG8_SA(0, 1), a2 + hstepA, voffA);
            PG8_WAIT_V(8); PG8_WAIT_L(0); PG8_BAR; PG8_MMA(0, 0, At, B0); PG8_MMA(0, 1, At, B1); PG8_BAR; PG8_SCHED;
            PG8_LDA(At, 1, 1); PG8_STAGE(PG8_SB(1, 0), b3, voffB); PG8_STAGE(PG8_SB(1, 1), b3 + hstepB, voffB); PG8_STAGE(PG8_SA(1, 0), a3, voffA);
            PG8_WAIT_V(8); PG8_WAIT_L(0); PG8_BAR; PG8_MMA(1, 0, At, B0); PG8_MMA(1, 1, At, B1); PG8_BAR; PG8_SCHED;
            } else {
            PG8_LDB(B0, 0, 0); PG8_SCHED; PG8_LDA(At, 0, 0); PG8_STAGE(PG8_SA(1, 1), a1 + hstepA, voffA);
            PG8_WAIT_L(8); PG8_BAR; PG8_WAIT_L(0); PG8_MMA(0, 0, At, B0); PG8_BAR; PG8_SCHED;
            PG8_LDB(B1, 0, 1); PG8_STAGE(PG8_SB(0, 0), b2, voffB);
            PG8_BAR; PG8_WAIT_L(0); PG8_MMA(0, 1, At, B1); PG8_BAR;
            PG8_LDA(At, 0, 1); PG8_STAGE(PG8_SA(0, 0), a2, voffA);
            PG8_BAR; PG8_WAIT_L(0); PG8_MMA(1, 0, At, B0); PG8_BAR; PG8_SCHED;
            PG8_STAGE(PG8_SB(0, 1), b2 + hstepB, voffB);
            PG8_WAIT_V(6); PG8_BAR; PG8_MMA(1, 1, At, B1); PG8_BAR;
            PG8_LDB(B0, 1, 0); PG8_SCHED; PG8_LDA(At, 1, 0); PG8_STAGE(PG8_SA(0, 1), a2 + hstepA, voffA);
            PG8_WAIT_L(8); PG8_BAR; PG8_WAIT_L(0); PG8_MMA(0, 0, At, B0); PG8_BAR; PG8_SCHED;
            PG8_LDB(B1, 1, 1); PG8_STAGE(PG8_SB(1, 0), b3, voffB);
            PG8_BAR; PG8_WAIT_L(0); PG8_MMA(0, 1, At, B1); PG8_BAR;
            PG8_LDA(At, 1, 1); PG8_STAGE(PG8_SA(1, 0), a3, voffA);
            PG8_BAR; PG8_WAIT_L(0); PG8_MMA(1, 0, At, B0); PG8_BAR; PG8_SCHED;
            PG8_STAGE(PG8_SB(1, 1), b3 + hstepB, voffB);
            PG8_WAIT_V(6); PG8_BAR; PG8_MMA(1, 1, At, B1); PG8_BAR;
            }
        }
        if constexpr (ALIGN_EPI) { if (wr == 0) PG8_BAR; }
        if constexpr (!Epi::AFTER_DRAIN) { E(acc, cur, wr, wc, fr, fq); S.done(cur); }
        if (!has_next) break;
#pragma unroll
        for (int a = 0; a < 2; ++a)
#pragma unroll
            for (int b = 0; b < 2; ++b)
#pragma unroll
                for (int m = 0; m < 4; ++m)
#pragma unroll
                    for (int n = 0; n < 2; ++n) acc[a][b][m][n] = (f32x4){0.f, 0.f, 0.f, 0.f};
        cur = nxt; cA = nA; cB = nB; ++ui;
        if constexpr (ALIGN_EPI) { if (wr == 1) PG8_BAR; }
    }
    PG8_WAIT_V(0);
    if constexpr (!ALIGN_EPI) { if (wr == 0) PG8_BAR; }
    PG8_BAR;
    if constexpr (Epi::AFTER_DRAIN) { E.fused(acc, cur, wr, wc, fr, fq, lds, wid, lane); S.done(cur); }
#undef PG8_SA
#undef PG8_SB
#undef PG8_STAGE
#undef PG8_LDA
#undef PG8_LDB
#undef PG8_MMA
#undef PG8_WAIT_V
#undef PG8_WAIT_L
#undef PG8_BAR
#undef PG8_SCHED
}

struct EpiBf16Plain {
    static constexpr bool PERM = true, AFTER_DRAIN = false;
    bf16_t* O; int ldc; size_t gO; int split_cols; size_t split_stride;
    __device__ __forceinline__ void operator()(const f32x4 (&acc)[2][2][4][2], const Unit& u, int wr, int wc, int fr, int fq) const {
        const int row0 = u.pm * BM + wr * 64 + fr; int colt = u.pn * BM; bf16_t* base = O + (size_t)u.g * gO;
        if (split_cols) { const int t = colt / split_cols; base += (size_t)t * split_stride; colt -= t * split_cols; }
        const int col0 = colt + wc * 32 + 8 * fq;
#pragma unroll
        for (int ai = 0; ai < 2; ++ai)
#pragma unroll
            for (int m = 0; m < 4; ++m) { bf16_t* rowp = base + (size_t)(row0 + ai * HALF + m * 16) * ldc + col0;
#pragma unroll
                for (int bj = 0; bj < 2; ++bj) { const f32x4 v0 = acc[ai][bj][m][0], v1 = acc[ai][bj][m][1];
                    u32x4 w; w.x = cvt_pk_bf16(v0[0], v0[1]); w.y = cvt_pk_bf16(v0[2], v0[3]); w.z = cvt_pk_bf16(v1[0], v1[1]); w.w = cvt_pk_bf16(v1[2], v1[3]);
                    *(u32x4*)(rowp + bj * HALF) = w; } }
    }
};
template <bool BASE_BF16, bool OUT_F32, bool OUT_BF16, bool SSQ> struct EpiResid {
    static constexpr bool PERM = true, AFTER_DRAIN = false;
    const void* base; float* out; bf16_t* ob; float* ssq;
    __device__ __forceinline__ void operator()(const f32x4 (&acc)[2][2][4][2], const Unit& u, int wr, int wc, int fr, int fq) const {
        const int row0 = u.pm * BM + wr * 64 + fr, col0 = u.pn * BM + wc * 32 + 8 * fq;
#pragma unroll
        for (int ai = 0; ai < 2; ++ai)
#pragma unroll
            for (int m = 0; m < 4; ++m) { const int r = row0 + ai * HALF + m * 16; const size_t off = (size_t)r * DM + col0; float s = 0.f;
#pragma unroll
                for (int bj = 0; bj < 2; ++bj) {
                    f32x4 b0, b1;
                    if (BASE_BF16) { const u32x4 bw = *(const u32x4*)((const bf16_t*)base + off + bj * HALF);
                        b0 = (f32x4){bf_lo(bw.x), bf_hi(bw.x), bf_lo(bw.y), bf_hi(bw.y)}; b1 = (f32x4){bf_lo(bw.z), bf_hi(bw.z), bf_lo(bw.w), bf_hi(bw.w)}; }
                    else { b0 = *(const f32x4*)((const float*)base + off + bj * HALF); b1 = *(const f32x4*)((const float*)base + off + bj * HALF + 4); }
                    const f32x4 v0 = acc[ai][bj][m][0] + b0, v1 = acc[ai][bj][m][1] + b1;
                    if (OUT_F32) { *(f32x4*)(out + off + bj * HALF) = v0; *(f32x4*)(out + off + bj * HALF + 4) = v1; }
                    if (OUT_BF16) { u32x4 w; w.x = cvt_pk_bf16(v0[0], v0[1]); w.y = cvt_pk_bf16(v0[2], v0[3]); w.z = cvt_pk_bf16(v1[0], v1[1]); w.w = cvt_pk_bf16(v1[2], v1[3]); *(u32x4*)(ob + off + bj * HALF) = w; }
                    if (SSQ) s += (v0[0] * v0[0] + v0[1] * v0[1]) + (v0[2] * v0[2] + v0[3] * v0[3]) + (v1[0] * v1[0] + v1[1] * v1[1]) + (v1[2] * v1[2] + v1[3] * v1[3]); }
                if (SSQ) { s += __shfl_xor(s, 16); s += __shfl_xor(s, 32); if (fq == 0) atomicAdd(ssq + r, s); } }
    }
};
template <int N> __device__ __forceinline__ float row_shr1(float x) {
    return __builtin_bit_cast(float, __builtin_amdgcn_update_dpp(0x3f800000, __builtin_bit_cast(int, x), 0x110 + N, 0xf, 0xf, false)); }
struct EpiHgrn {
    static constexpr bool PERM = true, AFTER_DRAIN = false;
    const float* ssq1; const float* lb; bf16_t* Qt; bf16_t* Kt; bf16_t* V; float* EBG;
    __device__ __forceinline__ void operator()(const f32x4 (&acc)[2][2][4][2], const Unit& u, int wr, int wc, int fr, int fq) const {
        const int row0 = u.pm * BM + wr * 64 + fr;
        if (u.pn >= 16) {
            const int col0 = (u.pn - 16) * BM + wc * 32 + 8 * fq;
#pragma unroll
            for (int ai = 0; ai < 2; ++ai)
#pragma unroll
                for (int m = 0; m < 4; ++m) { const int r = row0 + ai * HALF + m * 16; const float rs = __builtin_amdgcn_rsqf(ssq1[r] * (1.0f / DM) + EPS);
                    bf16_t* rowp = V + (size_t)r * EW + col0;
#pragma unroll
                    for (int bj = 0; bj < 2; ++bj) { const f32x4 v0 = acc[ai][bj][m][0] * rs, v1 = acc[ai][bj][m][1] * rs;
                        u32x4 w; w.x = cvt_pk_bf16(v0[0], v0[1]); w.y = cvt_pk_bf16(v0[2], v0[3]); w.z = cvt_pk_bf16(v1[0], v1[1]); w.w = cvt_pk_bf16(v1[2], v1[3]);
                        *(u32x4*)(rowp + bj * HALF) = w; } }
            return;
        }
        const int col = u.pn * HALF + wc * 32 + 8 * fq;
        const int lane = threadIdx.x & 63;
        float lbv[8];
#pragma unroll
        for (int e = 0; e < 8; ++e) lbv[e] = lb[col + e];
#pragma unroll
        for (int ai = 0; ai < 2; ++ai)
#pragma unroll
            for (int mp = 0; mp < 2; ++mp) {
                float P[2][8], qv[2][8], kv[2][8];
#pragma unroll
                for (int mm = 0; mm < 2; ++mm) { const int m = 2 * mp + mm, r = row0 + ai * HALF + m * 16; const float rs = __builtin_amdgcn_rsqf(ssq1[r] * (1.0f / DM) + EPS);
#pragma unroll
                    for (int e = 0; e < 8; ++e) { const float qr = acc[ai][0][m][e >> 2][e & 3] * rs, fp = acc[ai][1][m][e >> 2][e & 3] * rs;
                        const float f = lbv[e] + (1.0f - lbv[e]) * fast_sigmoid(fp);
                        float p = f; p *= row_shr1<1>(p); p *= row_shr1<2>(p); p *= row_shr1<4>(p); p *= row_shr1<8>(p);
                        P[mm][e] = p; qv[mm][e] = fast_silu(qr); kv[mm][e] = 1.0f - f; } }
#pragma unroll
                for (int e = 0; e < 8; ++e) P[1][e] *= __shfl(P[0][e], lane | 15);
#pragma unroll
                for (int mm = 0; mm < 2; ++mm) { const int m = 2 * mp + mm, r = row0 + ai * HALF + m * 16; float qt[8], kt[8];
#pragma unroll
                    for (int e = 0; e < 8; ++e) { qt[e] = qv[mm][e] * P[mm][e]; kt[e] = kv[mm][e] * __builtin_amdgcn_rcpf(fmaxf(P[mm][e], 1.8e-35f)); }
                    u32x4 wq, wk; wq.x = cvt_pk_bf16(qt[0], qt[1]); wq.y = cvt_pk_bf16(qt[2], qt[3]); wq.z = cvt_pk_bf16(qt[4], qt[5]); wq.w = cvt_pk_bf16(qt[6], qt[7]);
                    wk.x = cvt_pk_bf16(kt[0], kt[1]); wk.y = cvt_pk_bf16(kt[2], kt[3]); wk.z = cvt_pk_bf16(kt[4], kt[5]); wk.w = cvt_pk_bf16(kt[6], kt[7]);
                    *(u32x4*)(Qt + (size_t)r * EW + col) = wq; *(u32x4*)(Kt + (size_t)r * EW + col) = wk;
                    if (mm == 1 && fr == 15) { float* ep = EBG + (size_t)(r >> 5) * EW + col; *(f32x4*)ep = (f32x4){P[1][0], P[1][1], P[1][2], P[1][3]}; *(f32x4*)(ep + 4) = (f32x4){P[1][4], P[1][5], P[1][6], P[1][7]}; } }
            }
    }
};
struct EpiGate {
    static constexpr bool PERM = true, AFTER_DRAIN = false;
    const float* ssq1; const float* ssqh; const float* onorm; bf16_t* O;
    __device__ __forceinline__ void operator()(const f32x4 (&acc)[2][2][4][2], const Unit& u, int wr, int wc, int fr, int fq) const {
        const int row0 = u.pm * BM + wr * 64 + fr, col0 = u.pn * BM + wc * 32 + 8 * fq;
        f32x4 onv[2][2];
#pragma unroll
        for (int bj = 0; bj < 2; ++bj)
#pragma unroll
            for (int n = 0; n < 2; ++n) onv[bj][n] = *(const f32x4*)(onorm + col0 + bj * HALF + 4 * n);
#pragma unroll
        for (int ai = 0; ai < 2; ++ai)
#pragma unroll
            for (int m = 0; m < 4; ++m) { const int r = row0 + ai * HALF + m * 16; const float rs = __builtin_amdgcn_rsqf(ssq1[r] * (1.0f / DM) + EPS);
                bf16_t* rowp = O + (size_t)r * EW + col0;
#pragma unroll
                for (int bj = 0; bj < 2; ++bj) { const float rh = __builtin_amdgcn_rsqf(ssqh[(size_t)r * NHEAD + 2 * u.pn + bj] * (1.0f / HD) + EPS);
                    const u32x4 ov = *(const u32x4*)(rowp + bj * HALF); float x[8];
#pragma unroll
                    for (int e = 0; e < 8; ++e) { const unsigned wv = ov[e >> 1]; const float o = (e & 1) ? bf_hi(wv) : bf_lo(wv);
                        const float gt = fast_silu(acc[ai][bj][m][e >> 2][e & 3] * rs);
                        x[e] = o * rh * onv[bj][e >> 2][e & 3] * gt; }
                    u32x4 w; w.x = cvt_pk_bf16(x[0], x[1]); w.y = cvt_pk_bf16(x[2], x[3]); w.z = cvt_pk_bf16(x[4], x[5]); w.w = cvt_pk_bf16(x[6], x[7]);
                    *(u32x4*)(rowp + bj * HALF) = w; } }
    }
};
struct EpiScratch {
    static constexpr bool PERM = true, AFTER_DRAIN = false;
    bf16_t* O;
    __device__ __forceinline__ void operator()(const f32x4 (&acc)[2][2][4][2], const Unit& u, int wr, int wc, int fr, int fq) const {
        const int row0 = wr * 64 + fr; const int col0 = wc * 32 + 8 * fq;
#pragma unroll
        for (int ai = 0; ai < 2; ++ai)
#pragma unroll
            for (int m = 0; m < 4; ++m) { bf16_t* rowp = O + (size_t)(row0 + ai * HALF + m * 16) * 256 + col0;
#pragma unroll
                for (int bj = 0; bj < 2; ++bj) { const f32x4 v0 = acc[ai][bj][m][0], v1 = acc[ai][bj][m][1];
                    u32x4 w; w.x = cvt_pk_bf16(v0[0], v0[1]); w.y = cvt_pk_bf16(v0[2], v0[3]); w.z = cvt_pk_bf16(v1[0], v1[1]); w.w = cvt_pk_bf16(v1[2], v1[3]);
                    *(u32x4*)(rowp + bj * HALF) = w; } }
    }
};
struct EpiNone {
    static constexpr bool PERM = true, AFTER_DRAIN = false;
    __device__ __forceinline__ void operator()(const f32x4 (&acc)[2][2][4][2], const Unit&, int, int, int, int) const {
#pragma unroll
        for (int ai = 0; ai < 2; ++ai)
#pragma unroll
            for (int bj = 0; bj < 2; ++bj)
#pragma unroll
                for (int m = 0; m < 4; ++m)
#pragma unroll
                    for (int n = 0; n < 2; ++n) asm volatile("" :: "v"(acc[ai][bj][m][n]));
    }
};
}

#ifndef MK_N_LAUNCHES
#define MK_N_LAUNCHES 1
#endif
constexpr int N_PHASES = 11;

constexpr size_t MiB = 1u << 20, KiB = 1u << 10;
constexpr size_t WS_CTL = 0, CTL_ZERO_BYTES = 1 * MiB;
constexpr size_t WS_SSQ1 = 256 * KiB;
constexpr size_t WS_W1T = 1 * MiB;
constexpr size_t WS_WGT = 9 * MiB;
constexpr size_t WS_WINV = 11 * MiB;
constexpr size_t WS_WO0T = 15 * MiB;
constexpr size_t WS_HWIN = 19 * MiB;
constexpr size_t WS_HWOUT = 35 * MiB;
constexpr size_t WS_SMALL = 39 * MiB;
constexpr size_t WS_LB = WS_SMALL;
constexpr size_t WS_VGM = WS_SMALL + 320 * KiB;
constexpr size_t WS_ZM = WS_SMALL + 576 * KiB;
constexpr size_t WS_ZMB = WS_SMALL + 1152 * KiB;
constexpr size_t WS_A2M = WS_SMALL + 704 * KiB;
constexpr size_t WS_H1M = WS_SMALL + 832 * KiB;
constexpr size_t WS_FM = WS_SMALL + 896 * KiB;
constexpr size_t WS_IM = WS_SMALL + 1024 * KiB;
constexpr size_t WS_SMETA = WS_SMALL + 2048 * KiB;
constexpr size_t WS_LSEG = 1 * MiB;
constexpr size_t WS_DLOG = 17 * MiB;
constexpr size_t WS_EBG = 493 * MiB;
constexpr size_t WS_SSQH = 43 * MiB;
constexpr size_t WS_XN0 = 45 * MiB;
constexpr size_t WS_Z = 109 * MiB;
constexpr size_t WS_GATE = 237 * MiB;
constexpr size_t WS_A2 = 365 * MiB;
constexpr size_t WS_END = 501 * MiB;
constexpr int CW_TMO = 0, CW_CODE = 1, CW_BAR = 4096;

constexpr int RING_OFF = 0, RING_BYTES = 131072;
constexpr int LDSCTL_OFF = RING_BYTES, MISC_OFF = LDSCTL_OFF + 320;
constexpr int RED_OFF = 132 * 1024;
constexpr int RS_OFF = 140 * 1024;
constexpr int LDS_BYTES = 147456;

typedef GAS unsigned gu32;
#define RLX_AGENT __ATOMIC_RELAXED, __HIP_MEMORY_SCOPE_AGENT
#define LDS_WAIT() asm volatile("s_waitcnt lgkmcnt(0)" ::: "memory")
#define VM_WAIT() asm volatile("s_waitcnt vmcnt(0)" ::: "memory")

#define XB_TMO      128
#define XB_XCNT(j)  (256  + 64 * (j))
#define XB_XSUB(j)  (1280 + 64 * (j))
#define XB_XGEN(j)  (2304 + 64 * (j))
#define XB_TOP      3328
#define XB_TOPGEN   3392
#define XCD_BAR_WORDS 3456
#define XB_SPIN_CAP (1u << 18)

__device__ __forceinline__ unsigned xb_ld(unsigned* p)              { return __hip_atomic_load(p, __ATOMIC_RELAXED, __HIP_MEMORY_SCOPE_AGENT); }
__device__ __forceinline__ unsigned xb_add(unsigned* p, unsigned v) { return __hip_atomic_fetch_add(p, v, __ATOMIC_RELAXED, __HIP_MEMORY_SCOPE_AGENT); }
__device__ __forceinline__ unsigned xb_xcc_id() { return (unsigned)__builtin_amdgcn_s_getreg((3 << 11) | 20) & 0xFu; }
#define XB_SPIN(cond, bar) do { unsigned _sp = 0; while (cond) { __builtin_amdgcn_s_sleep(1); \
    if ((++_sp & 255u) == 0u) { if (xb_ld(&(bar)[XB_TMO])) break; if (_sp > XB_SPIN_CAP) { atomicAdd(&(bar)[XB_TMO], 1u); break; } } } } while (0)

struct XcdBarrier { unsigned* bar; unsigned x; volatile LAS unsigned* st; };

__device__ __forceinline__ XcdBarrier xcd_barrier_post(unsigned* bar, volatile LAS unsigned* st) {
    XcdBarrier b; b.bar = bar; b.x = xb_xcc_id(); b.st = st;
    if (threadIdx.x == 0) (void)xb_add(&bar[XB_XCNT(b.x)], 1u);
    return b;
}
__device__ __forceinline__ void xcd_barrier_complete(unsigned* bar, unsigned x, unsigned& nloc, unsigned& nx) {
    const unsigned G = gridDim.x * gridDim.y * gridDim.z;
    unsigned sum, cnt, mine, sp = 0u;
    for (;;) {
        sum = 0u; cnt = 0u; mine = 0u;
#pragma unroll
        for (unsigned j = 0; j < 16; ++j) { const unsigned c = xb_ld(&bar[XB_XCNT(j)]); sum += c; cnt += (c > 0u) ? 1u : 0u; mine = (j == x) ? c : mine; }
        if (sum == G) break;
        __builtin_amdgcn_s_sleep(1);
        if ((++sp & 255u) == 0u) { if (xb_ld(&bar[XB_TMO])) break; if (sp > XB_SPIN_CAP) { atomicAdd(&bar[XB_TMO], 1u); break; } }
    }
    nloc = mine > 0u ? mine : 1u; nx = cnt > 0u ? cnt : 1u;
}
__device__ __forceinline__ void xcd_barrier(const XcdBarrier& b) {
    asm volatile("s_waitcnt vmcnt(0)" ::: "memory");
    __syncthreads();
    if (threadIdx.x == 0) {
        unsigned* bar = b.bar;
        __builtin_amdgcn_s_waitcnt(0);
        unsigned nloc = b.st[0], nx = b.st[1];
        if (nloc == 0u) { xcd_barrier_complete(bar, b.x, nloc, nx); b.st[0] = nloc; b.st[1] = nx; }
        const unsigned old = xb_add(&bar[XB_XSUB(b.x)], 1u);
        const unsigned gen = old / nloc;
        if (old + 1u == (gen + 1u) * nloc) {
            __builtin_amdgcn_fence(__ATOMIC_RELEASE, "agent");
            asm volatile("s_waitcnt vmcnt(0)" ::: "memory");
            const unsigned og = xb_add(&bar[XB_TOP], 1u);
            const unsigned tg = og / nx;
            if (og + 1u == (tg + 1u) * nx) xb_add(&bar[XB_TOPGEN], 1u);
            else XB_SPIN(xb_ld(&bar[XB_TOPGEN]) == tg, bar);
            __builtin_amdgcn_fence(__ATOMIC_ACQUIRE, "agent");
            xb_add(&bar[XB_XGEN(b.x)], 1u);
            asm volatile("s_waitcnt vmcnt(0)" ::: "memory");
        } else {
            XB_SPIN(xb_ld(&bar[XB_XGEN(b.x)]) == gen, bar);
            __builtin_amdgcn_fence(__ATOMIC_ACQUIRE, "agent");
            asm volatile("s_waitcnt vmcnt(0)" ::: "memory");
        }
    }
    __syncthreads();
}

struct Frame {
    LAS unsigned char* lds;
    volatile LAS unsigned* MISC;
    gu32* ctl;
    int tid, lane, wave;
    int vcu, G;
    const float *x, *meta, *normw, *pwin, *pwgrp, *pscale, *pwout, *hwin, *hlb, *honorm, *hwout, *fnw;
    float* out;
    unsigned char* ws;
};
__device__ __forceinline__ float wave_sum(float v) {
#pragma unroll
    for (int o = 1; o < 64; o <<= 1) v += __shfl_xor(v, o);
    return v;
}

__device__ __forceinline__ void p0_transpose_item(const float* W, int ldw, int col0, int K, int Nsub, bf16_t* WT, int row_off, const float* kscale, LAS float* scr, int item, int lane) {
    const int nblk = Nsub / 32, kb = item / nblk, nb = item % nblk, k0 = 64 * kb, n0 = 32 * nb;
#pragma unroll
    for (int i = 0; i < 32; ++i) { const int kk = 2 * i + (lane >> 5); float v = W[(size_t)(k0 + kk) * ldw + col0 + n0 + (lane & 31)]; if (kscale) v *= kscale[k0 + kk]; scr[kk * 33 + (lane & 31)] = v; }
    LDS_WAIT(); asm volatile("" ::: "memory");
    const int c = lane & 7;
#pragma unroll
    for (int j = 0; j < 4; ++j) { const int n = (lane >> 3) + 8 * j; const LAS float* s = scr + (8 * c) * 33 + n;
        u32x4 o; o.x = pk2(s[0 * 33], s[1 * 33]); o.y = pk2(s[2 * 33], s[3 * 33]); o.z = pk2(s[4 * 33], s[5 * 33]); o.w = pk2(s[6 * 33], s[7 * 33]);
        *(GAS u32x4*)(WT + (size_t)(row_off + n0 + n) * K + k0 + 8 * c) = o; }
    LDS_WAIT(); asm volatile("" ::: "memory");
}
template <int NR> __device__ __forceinline__ void rms_rows_to_bf16(int lane, const float* xrow, const float* w, bf16_t* orow) {
    const GAS f32x4* wr = (const GAS f32x4*)w + lane;
    f32x4 v[NR][4];
#pragma unroll
    for (int i = 0; i < NR; ++i) { const GAS f32x4* xr = (const GAS f32x4*)(xrow + (size_t)i * DM) + lane;
#pragma unroll
        for (int j = 0; j < 4; ++j) v[i][j] = __builtin_nontemporal_load(xr + 64 * j); }
#pragma unroll
    for (int i = 0; i < NR; ++i) { float s = 0.f;
#pragma unroll
        for (int j = 0; j < 4; ++j) s += (v[i][j].x * v[i][j].x + v[i][j].y * v[i][j].y) + (v[i][j].z * v[i][j].z + v[i][j].w * v[i][j].w);
        const float rstd = 1.f / sqrtf(wave_sum(s) * (1.f / DM) + EPS);
        GAS unsigned long long* o8 = (GAS unsigned long long*)(orow + (size_t)i * DM) + lane;
#pragma unroll
        for (int j = 0; j < 4; ++j) { const f32x4 ww = wr[64 * j];
            o8[64 * j] = (unsigned long long)pk2(v[i][j].x * rstd * ww.x, v[i][j].y * rstd * ww.y) | ((unsigned long long)pk2(v[i][j].z * rstd * ww.z, v[i][j].w * rstd * ww.w) << 32); } }
}

__device__ __forceinline__ float mini_gemm16(Frame& F, int K, const float* W, int ldw, int ncol) {
    const LAS float* AT = (const LAS float*)(F.lds + RING_OFF); LAS float* red = (LAS float*)(F.lds + RED_OFF);
    const int ks = F.tid >> 4;
    float acc[16];
#pragma unroll
    for (int r = 0; r < 16; ++r) acc[r] = 0.f;
    for (int k0 = ks; k0 < K; k0 += 32 * 16) {
        float wv[16];
#pragma unroll
        for (int u = 0; u < 16; ++u) wv[u] = __builtin_nontemporal_load(W + (size_t)(k0 + 32 * u) * ldw + ncol);
#pragma unroll
        for (int u = 0; u < 16; ++u) { const float w = wv[u]; const LAS f32x4* a = (const LAS f32x4*)(AT + (k0 + 32 * u) * 16);
#pragma unroll
            for (int q = 0; q < 4; ++q) { const f32x4 av = a[q]; acc[4 * q + 0] += w * av.x; acc[4 * q + 1] += w * av.y; acc[4 * q + 2] += w * av.z; acc[4 * q + 3] += w * av.w; } } }
#pragma unroll
    for (int r = 0; r < 16; ++r) { acc[r] += __shfl_xor(acc[r], 16); acc[r] += __shfl_xor(acc[r], 32); }
    if (F.lane < 16) {
#pragma unroll
        for (int r = 0; r < 16; ++r) red[(F.wave * 16 + r) * 16 + F.lane] = acc[r]; }
    __syncthreads();
    float res = 0.f;
    if (F.tid < 256) {
#pragma unroll
        for (int w = 0; w < 8; ++w) res += red[(w * 16 + (F.tid >> 4)) * 16 + (F.tid & 15)]; }
    __syncthreads();
    return res;
}

__device__ __forceinline__ void meta_a(Frame& F) {
    LAS float* rsl = (LAS float*)(F.lds + RS_OFF); LAS float* AT = (LAS float*)(F.lds + RING_OFF);
    for (int r = F.wave; r < 16; r += NWAVES) { float s = 0.f;
        for (int k = F.lane; k < DM; k += 64) { const float v = F.meta[r * DM + k]; s += v * v; }
        s = wave_sum(s); if (F.lane == 0) rsl[r] = 1.f / sqrtf(s * (1.f / DM) + EPS); }
    __syncthreads();
    for (int i = F.tid; i < 16 * DM; i += NWAVES * 64) { const int r = i >> 10, k = i & (DM - 1); AT[k * 16 + r] = F.meta[i] * rsl[r] * F.normw[k]; }
    __syncthreads();
    float* VGM = (float*)(F.ws + WS_VGM);
    for (int bx = F.vcu; bx < 256; bx += F.G) { const int n = bx * 16 + (F.tid & 15);
        const float res = mini_gemm16(F, DM, F.pwin, 4096, n);
        if (F.tid < 256) VGM[(F.tid >> 4) * 4096 + n] = res; }
    __syncthreads();
}
__device__ __forceinline__ void meta_b(Frame& F) {
    LAS float* AT = (LAS float*)(F.lds + RING_OFF); LAS float* zt = (LAS float*)(F.lds + RED_OFF);
    const float* VGM = (const float*)(F.ws + WS_VGM); float* ZM = (float*)(F.ws + WS_ZM); float* A2M = (float*)(F.ws + WS_A2M);
    for (int bx = F.vcu; bx < 128; bx += F.G) { const int g = bx >> 5, n = bx * 16 + (F.tid & 15), d = n & 511;
        for (int i = F.tid; i < 16 * 512; i += NWAVES * 64) { const int r = i >> 9, c = i & 511; AT[c * 16 + r] = VGM[r * 4096 + 512 * g + c]; }
        __syncthreads();
        const float res = mini_gemm16(F, 512, F.pwgrp + (size_t)g * 512 * 512, 512, d);
        if (F.tid < 256) { zt[F.tid] = res; ZM[(F.tid >> 4) * EW + n] = res; ((bf16_t*)(F.ws + WS_ZMB))[(F.tid >> 4) * EW + n] = (bf16_t)f2bf(res); }
        __syncthreads();
        if (F.tid < 256) { const int r = F.tid >> 4, col = F.tid & 15, w = 2 << g, cnt = (r + 1) < w ? (r + 1) : w; float s = 0.f;
            for (int j = 0; j < cnt; ++j) s += zt[(r - j) * 16 + col];
            const float pz = s / (float)cnt - zt[r * 16 + col], gate = VGM[r * 4096 + EW + n];
            A2M[r * EW + n] = pz * F.pscale[n] * (gate / (1.f + expf(-gate))); }
        __syncthreads();
    }
}
__device__ __forceinline__ void meta_c(Frame& F) {
    LAS float* AT = (LAS float*)(F.lds + RING_OFF);
    const float* A2M = (const float*)(F.ws + WS_A2M); float* H1M = (float*)(F.ws + WS_H1M);
    for (int bx = F.vcu; bx < 64; bx += F.G) { const int n = bx * 16 + (F.tid & 15);
        for (int i = F.tid; i < 16 * EW; i += NWAVES * 64) { const int r = i >> 11, c = i & (EW - 1); AT[c * 16 + r] = A2M[i]; }
        __syncthreads();
        const float res = mini_gemm16(F, EW, F.pwout, DM, n);
        if (F.tid < 256) { const int r = F.tid >> 4; H1M[r * DM + n] = F.meta[r * DM + n] + res; }
        __syncthreads();
    }
}
__device__ __forceinline__ void meta_d(Frame& F) {
    LAS float* rsl = (LAS float*)(F.lds + RS_OFF); LAS float* AT = (LAS float*)(F.lds + RING_OFF);
    const float* H1M = (const float*)(F.ws + WS_H1M); const float* LB = (const float*)(F.ws + WS_LB); float* FM = (float*)(F.ws + WS_FM); float* IM = (float*)(F.ws + WS_IM);
    for (int r = F.wave; r < 16; r += NWAVES) { float s = 0.f;
        for (int k = F.lane; k < DM; k += 64) { const float v = H1M[r * DM + k]; s += v * v; }
        s = wave_sum(s); if (F.lane == 0) rsl[r] = 1.f / sqrtf(s * (1.f / DM) + EPS); }
    __syncthreads();
    for (int i = F.tid; i < 16 * DM; i += NWAVES * 64) { const int r = i >> 10, k = i & (DM - 1); AT[k * 16 + r] = H1M[i] * rsl[r] * F.normw[DM + k]; }
    __syncthreads();
    for (int bx = F.vcu; bx < 256; bx += F.G) { const int np = bx * 16 + (F.tid & 15);
        const float res = mini_gemm16(F, DM, F.hwin, 8192, EW + np);
        if (F.tid < 256) { const int r = F.tid >> 4;
            if (np < EW) { const float l = LB[np]; FM[r * EW + np] = l + (1.f - l) / (1.f + expf(-res)); }
            else IM[r * EW + np - EW] = res; } }
    __syncthreads();
}
__device__ __forceinline__ void meta_e(Frame& F) {
    const float* FM = (const float*)(F.ws + WS_FM); const float* IM = (const float*)(F.ws + WS_IM); float* SM = (float*)(F.ws + WS_SMETA);
    for (int e = F.vcu * (NWAVES * 64) + F.tid; e < NHEAD * HD * HD; e += F.G * NWAVES * 64) { const int h = e >> 14, k = (e >> 7) & 127, v = e & 127; float S = 0.f;
        for (int s = 0; s < NMETA; ++s) { const float f = FM[s * EW + h * HD + k]; S = f * S + (1.f - f) * IM[s * EW + h * HD + v]; }
        SM[e] = S; }
}

__device__ __forceinline__ void p0_prologue(Frame& F) {
    LAS float* scr = (LAS float*)(F.lds + RING_OFF + F.wave * 16384);
    const int gw = F.vcu * NWAVES + F.wave, NGW = F.G * NWAVES;
    bf16_t* WGT = (bf16_t*)(F.ws + WS_WGT); bf16_t* WINV = (bf16_t*)(F.ws + WS_WINV);
    constexpr int I_WG1 = (512 / 64) * (512 / 32), I_WG = 4 * I_WG1;
    for (int it = gw; it < I_WG; it += NGW) { const int g = it / I_WG1; p0_transpose_item(F.pwgrp + (size_t)g * 512 * 512, 512, 0, 512, 512, WGT + (size_t)g * 512 * 512, 0, nullptr, scr, it % I_WG1, F.lane); }
    for (int idx = F.vcu * (NWAVES * 64) + F.tid; idx < DM * EW / 8; idx += F.G * NWAVES * 64) { const int k = idx >> 8, c8 = idx & 255;
        const f32x4 a = *(const f32x4*)(F.pwin + (size_t)k * 4096 + c8 * 8), b = *(const f32x4*)(F.pwin + (size_t)k * 4096 + c8 * 8 + 4);
        u32x4 o; o.x = pk2(a.x, a.y); o.y = pk2(a.z, a.w); o.z = pk2(b.x, b.y); o.w = pk2(b.z, b.w);
        *(u32x4*)(WINV + (size_t)k * EW + c8 * 8) = o; }
    { float* LB = (float*)(F.ws + WS_LB);
      for (int c = F.vcu * (NWAVES * 64) + F.tid; c < EW; c += F.G * NWAVES * 64) LB[c] = 1.f / (1.f + expf(F.hlb[c] - F.hlb[EW + c])); }
}
__device__ __forceinline__ void p1_weights(Frame& F, int skip) {
    if ((int)blockIdx.x < skip) return;
    LAS float* scr = (LAS float*)(F.lds + RING_OFF + F.wave * 16384);
    const int gw = ((int)blockIdx.x - skip) * NWAVES + F.wave, NGW = (F.G - skip) * NWAVES;
    bf16_t* W1T = (bf16_t*)(F.ws + WS_W1T); bf16_t* WO0T = (bf16_t*)(F.ws + WS_WO0T); bf16_t* HWIN = (bf16_t*)(F.ws + WS_HWIN); bf16_t* HWOUT = (bf16_t*)(F.ws + WS_HWOUT);
    constexpr int I_GATE = (DM / 64) * (EW / 32), I_WO0 = (EW / 64) * (DM / 32), I_HWIN = (DM / 64) * (8192 / 32), I_HWOUT = I_WO0;
    constexpr int NITEMS = I_GATE + I_WO0 + I_HWIN + I_HWOUT;
    for (int it = gw; it < NITEMS; it += NGW) {
        int r = it;
        if (r < I_GATE) { p0_transpose_item(F.pwin, 4096, EW, DM, EW, W1T, EW, nullptr, scr, r, F.lane); continue; } r -= I_GATE;
        if (r < I_WO0) { p0_transpose_item(F.pwout, DM, 0, EW, DM, WO0T, 0, nullptr, scr, r, F.lane); continue; } r -= I_WO0;
        if (r < I_HWIN) {
            const int nb = r % (8192 / 32), col0 = 32 * nb, part = col0 >> 11, hh = (col0 & 2047) >> 7, j0 = col0 & 127;
            const int drow = part < 2 ? 256 * hh + 128 * part + j0 : col0;
            p0_transpose_item(F.hwin, 8192, col0, DM, 32, HWIN, drow, F.normw + DM, scr, r / (8192 / 32), F.lane); continue; } r -= I_HWIN;
        p0_transpose_item(F.hwout, DM, 0, EW, DM, HWOUT, 0, nullptr, scr, r, F.lane);
    }
}
__device__ __forceinline__ void xn0_pass(Frame& F, int skip) {
    bf16_t* XN0 = (bf16_t*)(F.ws + WS_XN0);
    if ((int)blockIdx.x < skip) return;
    const int gw = ((int)blockIdx.x - skip) * NWAVES + F.wave, NGW = (F.G - skip) * NWAVES;
    for (int m = 2 * gw; m < MROWS; m += 2 * NGW) rms_rows_to_bf16<2>(F.lane, F.x + (size_t)m * DM, F.normw, XN0 + (size_t)m * DM);
}

__device__ __forceinline__ float unpk(const u32x4& v, int e) { const unsigned w = v[e >> 1]; return (e & 1) ? bf_hi(w) : bf_lo(w); }
template <int W> __device__ __forceinline__ void pool_run(const bf16_t* Z, const bf16_t* Gt, bf16_t* A2, const bf16_t* ZMB, const float* scale, int row0, int c0) {
    const int s0 = row0 & (SEQ - 1);
    u32x4 ring[W]; float S[8], sc[8];
#pragma unroll
    for (int e = 0; e < 8; ++e) { S[e] = 0.f; sc[e] = scale[c0 + e]; }
    const bf16_t* hsrc = (s0 != 0 ? Z + (size_t)(row0 - W) * EW : ZMB + (size_t)(NMETA - W) * EW) + c0;
#pragma unroll
    for (int j = 0; j < W; ++j) { const u32x4 p = *(const u32x4*)(hsrc + (size_t)j * EW);
        ring[j] = p;
#pragma unroll
        for (int e = 0; e < 8; ++e) S[e] += unpk(p, e); }
    constexpr float invW = 1.0f / (float)W;
#pragma unroll W >= 8 ? 1 : 8 / W
    for (int r0 = 0; r0 < 64; r0 += W) {
#pragma unroll
        for (int j = 0; j < W; ++j) { const size_t off = (size_t)(row0 + r0 + j) * EW + c0;
            const u32x4 x = *(const u32x4*)(Z + off), gt = *(const u32x4*)(Gt + off); float o[8];
#pragma unroll
            for (int e = 0; e < 8; ++e) { const float xe = unpk(x, e); S[e] += xe - unpk(ring[j], e); o[e] = (S[e] * invW - xe) * sc[e] * fast_silu(unpk(gt, e)); }
            ring[j] = x;
            u32x4 w; w.x = pk2(o[0], o[1]); w.y = pk2(o[2], o[3]); w.z = pk2(o[4], o[5]); w.w = pk2(o[6], o[7]);
            *(u32x4*)(A2 + off) = w; }
    }
}
__device__ __forceinline__ void pool_phase(Frame& F) {
    const bf16_t* Z = (const bf16_t*)(F.ws + WS_Z); const bf16_t* Gt = (const bf16_t*)(F.ws + WS_GATE); bf16_t* A2 = (bf16_t*)(F.ws + WS_A2); const bf16_t* ZM = (const bf16_t*)(F.ws + WS_ZMB);
    for (int item = F.vcu * (NWAVES * 64) + F.tid; item < (MROWS / 64) * (EW / 8); item += F.G * NWAVES * 64) {
        const int cg = item & 255, rr = item >> 8, grp = __builtin_amdgcn_readfirstlane(cg >> 6), c0 = cg * 8, row0 = rr * 64;
        if (grp == 0) pool_run<2>(Z, Gt, A2, ZM, F.pscale, row0, c0);
        else if (grp == 1) pool_run<4>(Z, Gt, A2, ZM, F.pscale, row0, c0);
        else if (grp == 2) pool_run<8>(Z, Gt, A2, ZM, F.pscale, row0, c0);
        else pool_run<16>(Z, Gt, A2, ZM, F.pscale, row0, c0);
    }
}

constexpr int HSEG = 4;
__host__ __device__ constexpr int hseg_start(int s) { return s == 0 ? 0 : (s == 1 ? 2048 : (s == 2 ? 4096 : (s == 3 ? 6144 : SEQ))); }
constexpr int QT_STRIDE = 272, KT_STRIDE = 288, OT_STRIDE = 272;
constexpr int QT_TILE = 32 * QT_STRIDE, KT_TILE = 32 * KT_STRIDE, OT_TILE = 32 * OT_STRIDE;
constexpr int H_QT = 0, H_KT = H_QT + 2 * QT_TILE, H_VT = H_KT + 2 * KT_TILE, H_OT = H_VT + 2 * KT_TILE, H_EB = H_OT + 2 * OT_TILE, H_END = H_EB + 2 * 512;
static_assert(H_END <= RING_BYTES, "HGRN LDS map");
typedef short s16x4 __attribute__((ext_vector_type(4)));
typedef __bf16 bf16x2_t __attribute__((ext_vector_type(2)));
__device__ __forceinline__ unsigned cvtpk(float lo, float hi) { const f32x2 v = {lo, hi}; const bf16x2_t b = __builtin_convertvector(v, bf16x2_t); return __builtin_bit_cast(unsigned, b); }
__device__ __forceinline__ bf16x8 mk8(unsigned a, unsigned b, unsigned c, unsigned d) { const u32x4 v = {a, b, c, d}; return __builtin_bit_cast(bf16x8, v); }
__device__ __forceinline__ s16x4 tr_read(const LAS unsigned char* p) { return __builtin_amdgcn_ds_read_tr16_b64_v4i16((LAS s16x4*)p); }
__device__ __forceinline__ bf16x8 cat44(s16x4 a, s16x4 b) { return __builtin_shufflevector(a, b, 0, 1, 2, 3, 4, 5, 6, 7); }

template <bool PASSB> __device__ __forceinline__ void hgrn_pass(Frame& F) {
    bf16_t* Q = (bf16_t*)(F.ws + WS_Z); const bf16_t* Kg = (const bf16_t*)(F.ws + WS_GATE); const bf16_t* V = (const bf16_t*)(F.ws + WS_A2); const float* EBG = (const float*)(F.ws + WS_EBG);
    float* ssqh = (float*)(F.ws + WS_SSQH); const float* SM = (const float*)(F.ws + WS_SMETA); float* LS = (float*)(F.ws + WS_LSEG); float* DL = (float*)(F.ws + WS_DLOG);
    LAS unsigned char* L = F.lds;
    const int w = F.wave, lane = F.lane, r16 = lane & 15, q4 = lane >> 4, trq = r16 >> 2, trp = r16 & 3;
    const int t = F.tid >> 4, cg = F.tid & 15;
    for (int task = F.vcu; task < BATCH * NHEAD * HSEG; task += F.G) {
        const int seg = task & (HSEG - 1), bh = task >> 2, b = bh >> 4, h = bh & 15;
        if (!PASSB && seg == HSEG - 1) continue;
        const int s_beg = hseg_start(seg), nblk = (hseg_start(seg + 1) - s_beg) / 32;
        f32x4 S[8];
        if (PASSB) {
#pragma unroll
            for (int cb = 0; cb < 8; ++cb)
#pragma unroll
                for (int r = 0; r < 4; ++r) S[cb][r] = SM[(size_t)(h * HD + 16 * cb + 4 * q4 + r) * HD + 16 * w + r16];
            for (int i = 0; i < seg; ++i) { const float* Li = LS + (size_t)(bh * HSEG + i) * HD * HD; const float* Di = DL + (size_t)(bh * HSEG + i) * HD;
#pragma unroll
                for (int cb = 0; cb < 8; ++cb)
#pragma unroll
                    for (int r = 0; r < 4; ++r) { const int c = 16 * cb + 4 * q4 + r; S[cb][r] = Di[c] * S[cb][r] + Li[(size_t)c * HD + 16 * w + r16]; } }
        } else {
#pragma unroll
            for (int cb = 0; cb < 8; ++cb) S[cb] = (f32x4){0.f, 0.f, 0.f, 0.f};
        }
        f32x4 dprod = (f32x4){1.f, 1.f, 1.f, 1.f};
        const size_t gbase = ((size_t)b * SEQ + s_beg + t) * EW + h * HD + 8 * cg;
        const size_t ebase = ((size_t)b * SEQ + s_beg) / 32 * EW + h * HD + 4 * (F.tid & 31);
        u32x4 qvA = (u32x4){0u, 0u, 0u, 0u}, kvA = *(const u32x4*)(Kg + gbase), vvA = *(const u32x4*)(V + gbase);
        u32x4 qvB = (u32x4){0u, 0u, 0u, 0u}, kvB = *(const u32x4*)(Kg + gbase + (size_t)32 * EW), vvB = *(const u32x4*)(V + gbase + (size_t)32 * EW);
        f32x4 evA = *(const f32x4*)(EBG + ebase), evB = *(const f32x4*)(EBG + ebase + EW);
        if (PASSB) { qvA = *(const u32x4*)(Q + gbase); qvB = *(const u32x4*)(Q + gbase + (size_t)32 * EW); }
#define HG_BODY(it, qv, kv, vv, ev, DO_O, DO_R, DO_M) do { \
 \
            if (PASSB && DO_O) { const int n = it - 2; const size_t ooff = gbase + (size_t)n * 32 * EW; \
                const u32x4 ov = *(const LAS u32x4*)(L + H_OT + (n & 1) * OT_TILE + t * OT_STRIDE + cg * 16); \
                float ss = 0.f; \
_Pragma("unroll") \
                for (int e = 0; e < 8; ++e) { const float x = unpk(ov, e); ss += x * x; } \
                ss += __shfl_xor(ss, 1); ss += __shfl_xor(ss, 2); ss += __shfl_xor(ss, 4); ss += __shfl_xor(ss, 8); \
                *(u32x4*)(Q + ooff) = ov; \
                ssqh[(ooff / EW) * NHEAD + h] = ss; } \
 \
            if (DO_R) { const int p = it & 1; \
                *(LAS u32x4*)(L + H_KT + p * KT_TILE + t * KT_STRIDE + cg * 16) = kv; \
                *(LAS u32x4*)(L + H_VT + p * KT_TILE + t * KT_STRIDE + cg * 16) = vv; \
                if (PASSB) *(LAS u32x4*)(L + H_QT + p * QT_TILE + t * QT_STRIDE + cg * 16) = qv; \
                if (F.tid < 32) { *(LAS f32x4*)(L + H_EB + p * 512 + F.tid * 16) = ev; if (!PASSB) dprod = dprod * ev; } \
                { const int nb = (it + 2 < nblk) ? it + 2 : nblk - 1; const size_t go = gbase + (size_t)nb * 32 * EW; kv = *(const u32x4*)(Kg + go); vv = *(const u32x4*)(V + go); if (PASSB) qv = *(const u32x4*)(Q + go); \
                    ev = *(const f32x4*)(EBG + ebase + (size_t)nb * EW); } } \
 \
            if (DO_M) { const int p = (it - 1) & 1; \
                const LAS unsigned char* qt = L + H_QT + p * QT_TILE; const LAS unsigned char* kt = L + H_KT + p * KT_TILE; const LAS unsigned char* vt = L + H_VT + p * KT_TILE; \
                if (PASSB) { \
                    bf16x8 Sb[4]; \
_Pragma("unroll") \
                    for (int ks = 0; ks < 4; ++ks) Sb[ks] = mk8(cvtpk(S[2 * ks][0], S[2 * ks][1]), cvtpk(S[2 * ks][2], S[2 * ks][3]), cvtpk(S[2 * ks + 1][0], S[2 * ks + 1][1]), cvtpk(S[2 * ks + 1][2], S[2 * ks + 1][3])); \
                    f32x4 o[2] = {(f32x4){0.f, 0.f, 0.f, 0.f}, (f32x4){0.f, 0.f, 0.f, 0.f}}; \
_Pragma("unroll") \
                    for (int tb = 0; tb < 2; ++tb) \
_Pragma("unroll") \
                        for (int ks = 0; ks < 4; ++ks) { \
                            const LAS unsigned char* qa = qt + (16 * tb + r16) * QT_STRIDE + (32 * ks + 4 * q4) * 2; \
                            const u32x2 a0 = *(const LAS u32x2*)qa, a1 = *(const LAS u32x2*)(qa + 32); \
                            o[tb] = __builtin_amdgcn_mfma_f32_16x16x32_bf16(mk8(a0.x, a0.y, a1.x, a1.y), Sb[ks], o[tb], 0, 0, 0); } \
                    f32x4 at00 = (f32x4){0.f, 0.f, 0.f, 0.f}, at01 = at00, at11 = at00; \
_Pragma("unroll") \
                    for (int ks = 0; ks < 4; ++ks) { \
                        const bf16x8 k0 = *(const LAS bf16x8*)(kt + r16 * KT_STRIDE + (32 * ks + 8 * q4) * 2), k1 = *(const LAS bf16x8*)(kt + (16 + r16) * KT_STRIDE + (32 * ks + 8 * q4) * 2); \
                        const bf16x8 q0 = *(const LAS bf16x8*)(qt + r16 * QT_STRIDE + (32 * ks + 8 * q4) * 2), q1 = *(const LAS bf16x8*)(qt + (16 + r16) * QT_STRIDE + (32 * ks + 8 * q4) * 2); \
                        at00 = __builtin_amdgcn_mfma_f32_16x16x32_bf16(k0, q0, at00, 0, 0, 0); \
                        at01 = __builtin_amdgcn_mfma_f32_16x16x32_bf16(k0, q1, at01, 0, 0, 0); \
                        at11 = __builtin_amdgcn_mfma_f32_16x16x32_bf16(k1, q1, at11, 0, 0, 0); } \
_Pragma("unroll") \
                    for (int r = 0; r < 4; ++r) if (4 * q4 + r > r16) { at00[r] = 0.f; at11[r] = 0.f; } \
                    const bf16x8 Bv = cat44(tr_read(vt + (4 * q4 + trq) * KT_STRIDE + (16 * w + 4 * trp) * 2), tr_read(vt + (16 + 4 * q4 + trq) * KT_STRIDE + (16 * w + 4 * trp) * 2)); \
                    o[0] = __builtin_amdgcn_mfma_f32_16x16x32_bf16(mk8(cvtpk(at00[0], at00[1]), cvtpk(at00[2], at00[3]), 0u, 0u), Bv, o[0], 0, 0, 0); \
                    o[1] = __builtin_amdgcn_mfma_f32_16x16x32_bf16(mk8(cvtpk(at01[0], at01[1]), cvtpk(at01[2], at01[3]), cvtpk(at11[0], at11[1]), cvtpk(at11[2], at11[3])), Bv, o[1], 0, 0, 0); \
_Pragma("unroll") \
                    for (int tb = 0; tb < 2; ++tb) \
_Pragma("unroll") \
                        for (int r = 0; r < 4; ++r) *(LAS bf16_t*)(L + H_OT + p * OT_TILE + (16 * tb + 4 * q4 + r) * OT_STRIDE + (16 * w + r16) * 2) = (bf16_t)(cvtpk(o[tb][r], 0.f) & 0xffffu); \
                } \
                const bf16x8 Bs = cat44(tr_read(vt + (8 * q4 + trq) * KT_STRIDE + (16 * w + 4 * trp) * 2), tr_read(vt + (8 * q4 + 4 + trq) * KT_STRIDE + (16 * w + 4 * trp) * 2)); \
_Pragma("unroll") \
                for (int cb = 0; cb < 8; ++cb) { \
                    const bf16x8 Ak = cat44(tr_read(kt + (8 * q4 + trq) * KT_STRIDE + (16 * cb + 4 * trp) * 2), tr_read(kt + (8 * q4 + 4 + trq) * KT_STRIDE + (16 * cb + 4 * trp) * 2)); \
                    S[cb] = __builtin_amdgcn_mfma_f32_16x16x32_bf16(Ak, Bs, S[cb], 0, 0, 0); } \
_Pragma("unroll") \
                for (int cb = 0; cb < 8; ++cb) { const f32x4 ebv = *(const LAS f32x4*)(L + H_EB + p * 512 + (16 * cb + 4 * q4) * 4); S[cb] = S[cb] * ebv; } \
            } \
            __syncthreads(); \
 \
        } while (0)
        HG_BODY(0, qvA, kvA, vvA, evA, 0, 1, 0); HG_BODY(1, qvB, kvB, vvB, evB, 0, 1, 1);
        for (int it2 = 2; it2 < nblk; it2 += 2) { HG_BODY(it2, qvA, kvA, vvA, evA, 1, 1, 1); HG_BODY((it2 + 1), qvB, kvB, vvB, evB, 1, 1, 1); }
        HG_BODY(nblk, qvA, kvA, vvA, evA, 1, 0, 1); HG_BODY((nblk + 1), qvB, kvB, vvB, evB, 1, 0, 0);
#undef HG_BODY
        if (!PASSB) {
            float* Lo = LS + (size_t)(bh * HSEG + seg) * HD * HD;
#pragma unroll
            for (int cb = 0; cb < 8; ++cb)
#pragma unroll
                for (int r = 0; r < 4; ++r) Lo[(size_t)(16 * cb + 4 * q4 + r) * HD + 16 * w + r16] = S[cb][r];
            if (F.tid < 32) *(f32x4*)(DL + (size_t)(bh * HSEG + seg) * HD + 4 * F.tid) = dprod;
        }
        __syncthreads();
    }
}

__device__ __forceinline__ void final_norm(Frame& F) {
    const int gw = F.vcu * NWAVES + F.wave, NGW = F.G * NWAVES;
    for (int m = gw; m < MROWS; m += NGW) {
        GAS f32x4* xr = (GAS f32x4*)(F.out + (size_t)m * DM) + F.lane; const GAS f32x4* wr = (const GAS f32x4*)F.fnw + F.lane;
        f32x4 v[4]; float s = 0.f;
#pragma unroll
        for (int j = 0; j < 4; ++j) { v[j] = xr[64 * j]; s += (v[j].x * v[j].x + v[j].y * v[j].y) + (v[j].z * v[j].z + v[j].w * v[j].w); }
        const float rstd = 1.f / sqrtf(wave_sum(s) * (1.f / DM) + EPS);
#pragma unroll
        for (int j = 0; j < 4; ++j) { const f32x4 ww = wr[64 * j]; xr[64 * j] = (f32x4){v[j].x * rstd * ww.x, v[j].y * rstd * ww.y, v[j].z * rstd * ww.z, v[j].w * rstd * ww.w}; }
    }
}

__device__ __forceinline__ void stagger_wait(Frame& F, unsigned ticks  ) {
    if (F.vcu & 1) { const unsigned long long t0 = __builtin_amdgcn_s_memrealtime(); while (__builtin_amdgcn_s_memrealtime() - t0 < ticks) __builtin_amdgcn_s_sleep(8); }
}
struct Args { const float* in[12]; float* out; unsigned char* ws; int ph_lo, ph_hi; };
__global__ void __launch_bounds__(NWAVES * 64, 2) trunk_fwd(Args args) {
    extern __shared__ __attribute__((aligned(16))) unsigned char lds[];
    Frame F;
    F.lds = (LAS unsigned char*)lds;
    F.MISC = (volatile LAS unsigned*)(F.lds + MISC_OFF);
    F.tid = threadIdx.x; F.lane = F.tid & 63; F.wave = __builtin_amdgcn_readfirstlane(F.tid >> 6);
    F.G = gridDim.x; { const int bx = blockIdx.x; F.vcu = (F.G % 8 == 0) ? (bx % 8) * (F.G / 8) + bx / 8 : bx; }
    F.ws = args.ws; F.ctl = (gu32*)(args.ws + WS_CTL);
    F.x = args.in[0]; F.meta = args.in[1]; F.normw = args.in[2]; F.pwin = args.in[3]; F.pwgrp = args.in[4]; F.pscale = args.in[5]; F.pwout = args.in[6];
    F.hwin = args.in[7]; F.hlb = args.in[8]; F.honorm = args.in[9]; F.hwout = args.in[10]; F.fnw = args.in[11]; F.out = args.out;
    for (int u = F.tid; u < (LDS_BYTES - LDSCTL_OFF) / 4; u += NWAVES * 64) ((LAS unsigned*)(F.lds + LDSCTL_OFF))[u] = 0u;
    __syncthreads();
    XcdBarrier bar; bar.bar = (unsigned*)(F.ctl + CW_BAR); bar.x = 0; bar.st = nullptr;
    if (MK_N_LAUNCHES == 1) bar = xcd_barrier_post((unsigned*)(F.ctl + CW_BAR), F.MISC + 8);
    const int lo = args.ph_lo, hi = args.ph_hi;
#define IN(k) (lo <= (k) && (k) < hi)
#ifdef PROBE_T
    unsigned long long ts[13]; int nts = 0;
#define STAMP() do { ts[nts] = __builtin_amdgcn_s_memrealtime(); if (nts == PROBE_B && blockIdx.x == 0) { const unsigned long long dt = (ts[PROBE_B] - ts[PROBE_A]) * PROBE_MULT, t0 = ts[nts]; \
        while (__builtin_amdgcn_s_memrealtime() - t0 < dt) __builtin_amdgcn_s_sleep(16); } ++nts; } while (0)
#else
#define STAMP() do { } while (0)
#endif
#define SEAM(k) do { if (IN(k) && IN((k) + 1)) xcd_barrier(bar); STAMP(); } while (0)
    STAMP();
    bf16_t* const W1T = (bf16_t*)(F.ws + WS_W1T); bf16_t* const WGT = (bf16_t*)(F.ws + WS_WGT); bf16_t* const WINV = (bf16_t*)(F.ws + WS_WINV); bf16_t* const WO0T = (bf16_t*)(F.ws + WS_WO0T);
    bf16_t* const HWIN = (bf16_t*)(F.ws + WS_HWIN); bf16_t* const HWOUT = (bf16_t*)(F.ws + WS_HWOUT);
    bf16_t* const XN0 = (bf16_t*)(F.ws + WS_XN0); bf16_t* const H1B = XN0; bf16_t* const ZB = (bf16_t*)(F.ws + WS_Z); bf16_t* const GB = (bf16_t*)(F.ws + WS_GATE); bf16_t* const A2B = (bf16_t*)(F.ws + WS_A2);
    float* const SSQ1 = (float*)(F.ws + WS_SSQ1); float* const SSQH = (float*)(F.ws + WS_SSQH); const float* const LB = (const float*)(F.ws + WS_LB);

    if (IN(0)) { meta_a(F); p0_prologue(F); }
    SEAM(0);
    if (IN(1)) {
        meta_b(F);
        pg8::Gemm g{WGT, WINV}; pg8::GroupOrder S{2, 4, 4, F.G, (int)blockIdx.x};
        pg8::EpiBf16Plain E{W1T, DM, (size_t)512 * DM, 0, 0};
        pg8::gemm_phase<pg8::EpiBf16Plain, pg8::GroupOrder, false, true, 512, 512, EW, 512 * 512, 512>(F.lds + RING_OFF, g, S, E);
        p1_weights(F, F.G >= 64 ? 32 : 0); xn0_pass(F, F.G >= 64 ? 32 : 0);
    }
    SEAM(1);
    if (IN(2)) {
        meta_c(F);
        pg8::Gemm g{XN0, W1T}; pg8::StaticOrder S; S.init(MROWS, 4096, F.G, (int)blockIdx.x);
        pg8::EpiBf16Plain E{ZB, EW, 0, EW, (size_t)(WS_GATE - WS_Z) / 2};
        pg8::gemm_phase<pg8::EpiBf16Plain, pg8::StaticOrder, true, true, DM, DM, DM>(F.lds + RING_OFF, g, S, E);
    }
    SEAM(2);
    if (IN(3)) { meta_d(F); pool_phase(F); }
    SEAM(3);
    if (IN(4)) {
        meta_e(F);
        pg8::Gemm g{A2B, WO0T}; pg8::StaticOrder S; S.init(MROWS, DM, F.G, (int)blockIdx.x);
        typedef pg8::EpiResid<false, false, true, true> Epi4;
        Epi4 E{F.x, nullptr, H1B, SSQ1};
        pg8::gemm_phase<Epi4, pg8::StaticOrder, true, true, EW, EW, EW>(F.lds + RING_OFF, g, S, E);
    }
    SEAM(4);
    if (IN(5)) {
        pg8::Gemm g{H1B, HWIN}; pg8::StaticOrder S; S.init(MROWS, 6144, F.G, (int)blockIdx.x);
        static_assert(WS_GATE - WS_Z == WS_A2 - WS_GATE, "Q, G, V equally spaced"); pg8::EpiHgrn E{SSQ1, LB, ZB, GB, A2B, (float*)(F.ws + WS_EBG)};
        pg8::gemm_phase<pg8::EpiHgrn, pg8::StaticOrder, true, true, DM, DM, DM>(F.lds + RING_OFF, g, S, E);
    }
    SEAM(5);
    if (IN(6)) hgrn_pass<false>(F);
    SEAM(6);
    if (IN(7)) hgrn_pass<true>(F);
    SEAM(7);
    if (IN(8)) {
        pg8::Gemm g{H1B, HWIN + (size_t)6144 * DM}; pg8::StaticOrder S; S.init(MROWS, EW, F.G, (int)blockIdx.x);
        pg8::EpiGate E{SSQ1, SSQH, F.honorm, ZB};
        pg8::gemm_phase<pg8::EpiGate, pg8::StaticOrder, true, true, DM, DM, DM>(F.lds + RING_OFF, g, S, E);
    }
    SEAM(8);
    if (IN(9)) {
        pg8::Gemm g{ZB, HWOUT}; pg8::StaticOrder S; S.init(MROWS, DM, F.G, (int)blockIdx.x);
        typedef pg8::EpiResid<true, true, false, false> Epi9;
        Epi9 E{H1B, F.out, nullptr, nullptr};
        pg8::gemm_phase<Epi9, pg8::StaticOrder, true, true, EW, EW, EW>(F.lds + RING_OFF, g, S, E);
    }
    SEAM(9);
    if (IN(10)) final_norm(F);
#ifdef PROBE_T
    xcd_barrier(bar); STAMP();
#endif
#undef IN
#undef SEAM
}

extern "C" void kernel_launch(void* const* d_in, const int* in_sizes, int n_in, void* d_out, int out_size, void* d_ws, size_t ws_size, hipStream_t stream) {
    static int grid = 0;
    if (grid == 0) {
        if (n_in != 12 || in_sizes[0] != MROWS * DM || out_size != MROWS * DM || ws_size < WS_END) { fprintf(stderr, "kernel_launch: unexpected shapes (n_in %d, in0 %d, out %d, ws %zu); nothing launched\n", n_in, n_in > 0 ? in_sizes[0] : -1, out_size, ws_size); grid = -1; return; }
        int dev = 0, cus = 0, per_cu = 0;
        if (hipGetDevice(&dev) != hipSuccess || hipDeviceGetAttribute(&cus, hipDeviceAttributeMultiprocessorCount, dev) != hipSuccess) { fprintf(stderr, "kernel_launch: device query failed\n"); grid = -1; return; }
        if (hipFuncSetAttribute((const void*)trunk_fwd, hipFuncAttributeMaxDynamicSharedMemorySize, LDS_BYTES) != hipSuccess) { fprintf(stderr, "kernel_launch: hipFuncSetAttribute failed\n"); grid = -1; return; }
        if (hipOccupancyMaxActiveBlocksPerMultiprocessor(&per_cu, (const void*)trunk_fwd, NWAVES * 64, LDS_BYTES) != hipSuccess || per_cu < 1)
            fprintf(stderr, "kernel_launch: note: occupancy query reports %d workgroups per CU\n", per_cu);
        (void)hipGetLastError();
        grid = cus;
    }
    if (grid < 0) return;
    if (hipMemsetAsync((char*)d_ws + WS_CTL, 0, CTL_ZERO_BYTES, stream) != hipSuccess) { fprintf(stderr, "kernel_launch: hipMemsetAsync failed\n"); return; }
    Args a{};
    for (int i = 0; i < 12; ++i) a.in[i] = (const float*)d_in[i];
    a.out = (float*)d_out; a.ws = (unsigned char*)d_ws;
#if MK_N_LAUNCHES == 1
    a.ph_lo = 0; a.ph_hi = N_PHASES;
    hipLaunchKernelGGL(trunk_fwd, dim3(grid), dim3(NWAVES * 64), LDS_BYTES, stream, a);
#else
    for (int p = 0; p < N_PHASES; ++p) { a.ph_lo = p; a.ph_hi = p + 1; hipLaunchKernelGGL(trunk_fwd, dim3(grid), dim3(NWAVES * 64), LDS_BYTES, stream, a); }
#endif
    const hipError_t le = hipPeekAtLastError();
    if (le != hipSuccess) fprintf(stderr, "kernel_launch: launch failed: %s\n", hipGetErrorName(le));
}
```
